# Optimizing an MI355X kernel written in HIP

```python
import math
import jax, jax.numpy as jnp
from jax import lax
import numpy as np

D_MODEL = 1024
BATCH = 8
SEQ = 4096
DEPTH = 2

GRID_W = 64
CTX_LEN = 256
HEAD_DIM = 64
ROPE_BASE = 10000.0
EPS = 1e-6
NEG_INF = -1e30
ATTN_SCALE = HEAD_DIM ** -0.5
Q_BLOCK = 128
CHUNK = 128
A_GROUPS = 4
A_GROUP_DIM = 128
A_WIDTH = A_GROUPS * A_GROUP_DIM
B_HEADS = 4
B_QK_WIDTH = 2 * B_HEADS * HEAD_DIM
B_V_DIM = 2 * HEAD_DIM
B_V_WIDTH = B_HEADS * B_V_DIM
KV_START = 2 * A_WIDTH + B_QK_WIDTH
EVEN_IN = 2 * A_WIDTH + 2 * B_QK_WIDTH + B_V_WIDTH
EVEN_OUT = A_WIDTH + B_V_WIDTH
C_HEADS = 16
C_KV_HEADS = 4
C_GROUP = C_HEADS // C_KV_HEADS
WINDOW = 128
C_Q_WIDTH = C_HEADS * HEAD_DIM
C_KV_WIDTH = C_KV_HEADS * HEAD_DIM
C_IN = C_Q_WIDTH + 2 * C_KV_WIDTH
FFN_HIDDEN = ((8 * D_MODEL + 3 * 256 - 1) // (3 * 256)) * 256
N_EVEN = (DEPTH + 1) // 2
N_ODD = DEPTH // 2

kernel_name = 'hybrid_prefix_gmlp_diffattn_swa_block'


def rmsnorm(x, g):
    xf = x.astype(jnp.float32)
    y = xf * lax.rsqrt(jnp.mean(xf * xf, axis=-1, keepdims=True) + EPS)
    return (y * g.astype(jnp.float32)).astype(x.dtype)


def modulate(x, g, shift, scale):
    return rmsnorm(x, g) * (1 + scale) + shift


def rope_tables(s_len, dtype):
    rows = s_len // GRID_W
    row = jnp.repeat(jnp.arange(rows), GRID_W).astype(jnp.float32)
    col = jnp.tile(jnp.arange(GRID_W), rows).astype(jnp.float32)
    nf = HEAD_DIM // 4
    inv = ROPE_BASE ** (-jnp.arange(nf, dtype=jnp.float32) / nf)
    ang = jnp.stack([row[:, None] * inv, col[:, None] * inv], axis=1)
    ang = jnp.broadcast_to(ang[:, :, None, :], (s_len, 2, 2, nf)).reshape(s_len, HEAD_DIM)
    return jnp.cos(ang).astype(dtype), jnp.sin(ang).astype(dtype)


def apply_rope(x, cos, sin):
    xr = x.reshape(x.shape[:-1] + (2, 2, HEAD_DIM // 4))
    rot = jnp.stack([-xr[..., 1, :], xr[..., 0, :]], axis=-2).reshape(x.shape)
    return x * cos[None, :, None, :] + rot * sin[None, :, None, :]


def swiglu(h, w_in, w_out):
    g, u = jnp.split(h @ w_in, 2, axis=-1)
    return (jax.nn.silu(g) * u) @ w_out


def chunk_mlp(u, v, w_s, b_s):
    b, t, _ = u.shape
    shp = (b, t // CHUNK, CHUNK, A_GROUPS, A_GROUP_DIM)
    u = jax.nn.gelu(u, approximate=False).reshape(shp)
    vf = jax.nn.gelu(v.astype(jnp.float32), approximate=False).reshape(shp)
    mu = jnp.mean(vf, axis=-1, keepdims=True)
    vf = (vf - mu) * lax.rsqrt(jnp.mean(jnp.square(vf - mu), axis=-1, keepdims=True) + EPS)
    mixed = jnp.einsum('gpq,bnqgc->bnpgc', w_s.astype(jnp.float32), vf) + b_s.astype(jnp.float32).T[None, None, :, :, None]
    return (u * mixed.astype(u.dtype)).reshape(b, t, A_WIDTH)


def diff_attn(q, k, v, lam):
    b, tq = q.shape[0], q.shape[1]
    tk = k.shape[1]
    s = jnp.einsum('bqhd,bkhd->bhqk', q, k).astype(jnp.float32) * ATTN_SCALE
    p = jax.nn.softmax(s, axis=-1).reshape(b, B_HEADS, 2, tq, tk)
    a = p[:, :, 0] - lam * p[:, :, 1]
    return jnp.einsum('bhqk,bkhe->bqhe', a.astype(v.dtype), v)


def diff_out(o, g, lam_init):
    b, t = o.shape[0], o.shape[1]
    return (rmsnorm(o, g) * (1.0 - lam_init)).reshape(b, t, B_V_WIDTH)


def sink_attend(q, kvs, sink):
    scores = []
    for k, v, mask in kvs:
        s = jnp.einsum('bqhgd,bkhd->bhgqk', q, k).astype(jnp.float32) * ATTN_SCALE
        if mask is not None:
            s = jnp.where(mask, s, NEG_INF)
        scores.append(s)
    s_sink = jnp.broadcast_to(sink.astype(jnp.float32).reshape(1, C_KV_HEADS, C_GROUP, 1, 1), scores[0].shape[:-1] + (1,))
    p = jax.nn.softmax(jnp.concatenate(scores + [s_sink], axis=-1), axis=-1)
    out = None
    start = 0
    for k, v, _ in kvs:
        tk = k.shape[1]
        o = jnp.einsum('bhgqk,bkhd->bqhgd', p[..., start:start + tk].astype(v.dtype), v)
        out = o if out is None else out + o
        start += tk
    return out


def even_mixer(h, hc, w_in, w_out, w_s, b_s, lq1, lk1, lq2, lk2, subln_g, lam_init, cos, sin, need_ctx):
    b, s_len, _ = h.shape
    nb = s_len // Q_BLOCK
    f32 = jnp.float32
    lam = (jnp.exp(jnp.sum(lq1.astype(f32) * lk1.astype(f32)))
           - jnp.exp(jnp.sum(lq2.astype(f32) * lk2.astype(f32))) + lam_init)
    u, v, q, k, vv = jnp.split(h @ w_in, [A_WIDTH, 2 * A_WIDTH, KV_START, KV_START + B_QK_WIDTH], axis=-1)
    q = apply_rope(q.reshape(b, s_len, 2 * B_HEADS, HEAD_DIM), cos, sin)
    k = apply_rope(k.reshape(b, s_len, 2 * B_HEADS, HEAD_DIM), cos, sin)
    vv = vv.reshape(b, s_len, B_HEADS, B_V_DIM)
    kc, vvc = jnp.split(hc @ w_in[:, KV_START:], [B_QK_WIDTH], axis=-1)
    kc = kc.reshape(b, -1, 2 * B_HEADS, HEAD_DIM)
    vvc = vvc.reshape(b, -1, B_HEADS, B_V_DIM)
    k_all = jnp.concatenate([k, kc], axis=1)
    v_all = jnp.concatenate([vv, vvc], axis=1)
    q_blocks = q.reshape(b, nb, Q_BLOCK, 2 * B_HEADS, HEAD_DIM).transpose(1, 0, 2, 3, 4)
    o = lax.map(lambda qb: diff_attn(qb, k_all, v_all, lam), q_blocks)
    o = o.transpose(1, 0, 2, 3, 4).reshape(b, s_len, B_HEADS, B_V_DIM)
    y = jnp.concatenate([chunk_mlp(u, v, w_s, b_s), diff_out(o, subln_g, lam_init)], axis=-1) @ w_out
    yc = None
    if need_ctx:
        uc, vc_, qc = jnp.split(hc @ w_in[:, :KV_START], [A_WIDTH, 2 * A_WIDTH], axis=-1)
        qc = qc.reshape(b, -1, 2 * B_HEADS, HEAD_DIM)
        oc = diff_attn(qc, kc, vvc, lam)
        yc = jnp.concatenate([chunk_mlp(uc, vc_, w_s, b_s), diff_out(oc, subln_g, lam_init)], axis=-1) @ w_out
    return y, yc


def odd_mixer(h, hc, w_qkv, w_out, sink, cos, sin, need_ctx):
    b, s_len, _ = h.shape
    nb = s_len // Q_BLOCK
    q, k, v = jnp.split(h @ w_qkv, [C_Q_WIDTH, C_Q_WIDTH + C_KV_WIDTH], axis=-1)
    q = apply_rope(q.reshape(b, s_len, C_HEADS, HEAD_DIM), cos, sin).reshape(b, s_len, C_KV_HEADS, C_GROUP, HEAD_DIM)
    k = apply_rope(k.reshape(b, s_len, C_KV_HEADS, HEAD_DIM), cos, sin)
    v = v.reshape(b, s_len, C_KV_HEADS, HEAD_DIM)
    kc, vc = jnp.split(hc @ w_qkv[:, C_Q_WIDTH:], 2, axis=-1)
    kc = kc.reshape(b, -1, C_KV_HEADS, HEAD_DIM)
    vc = vc.reshape(b, -1, C_KV_HEADS, HEAD_DIM)
    pad = ((0, 0), (WINDOW, WINDOW), (0, 0), (0, 0))
    k_pad = jnp.pad(k, pad)
    v_pad = jnp.pad(v, pad)
    band = Q_BLOCK + 2 * WINDOW
    q_blocks = q.reshape(b, nb, Q_BLOCK, C_KV_HEADS, C_GROUP, HEAD_DIM).transpose(1, 0, 2, 3, 4, 5)

    def block(args):
        i, qb = args
        start = i * Q_BLOCK
        kb = lax.dynamic_slice_in_dim(k_pad, start, band, axis=1)
        vb = lax.dynamic_slice_in_dim(v_pad, start, band, axis=1)
        qpos = start + jnp.arange(Q_BLOCK)
        kpos = start - WINDOW + jnp.arange(band)
        mask = ((kpos >= 0)[None, :] & (kpos < s_len)[None, :]
                & (jnp.abs(qpos[:, None] - kpos[None, :]) <= WINDOW))
        return sink_attend(qb, [(kb, vb, mask), (kc, vc, None)], sink)

    o = lax.map(block, (jnp.arange(nb), q_blocks))
    y = o.transpose(1, 0, 2, 3, 4, 5).reshape(b, s_len, C_Q_WIDTH) @ w_out
    yc = None
    if need_ctx:
        qc = (hc @ w_qkv[:, :C_Q_WIDTH]).reshape(b, -1, C_KV_HEADS, C_GROUP, HEAD_DIM)
        yc = sink_attend(qc, [(kc, vc, None)], sink).reshape(b, -1, C_Q_WIDTH) @ w_out
    return y, yc


def setup_inputs(seed: int = 0) -> dict:
    key = jax.random.key(seed)
    ks = jax.random.split(key, 24)
    n = jax.random.normal
    f32 = jnp.float32
    return {
        'x': n(ks[0], (BATCH, SEQ, D_MODEL), f32),
        'c': n(ks[1], (BATCH, D_MODEL), f32),
        'ctx': n(ks[2], (BATCH, CTX_LEN, D_MODEL), f32),
        'c_ctx': n(ks[3], (D_MODEL,), f32),
        'ada_w': n(ks[4], (DEPTH, D_MODEL, 6 * D_MODEL), f32) * (0.5 * D_MODEL ** -0.5),
        'ada_b': n(ks[5], (DEPTH, 6 * D_MODEL), f32) * 0.02,
        'norm1_g': 1.0 + 0.02 * n(ks[6], (DEPTH, D_MODEL), f32),
        'norm2_g': 1.0 + 0.02 * n(ks[7], (DEPTH, D_MODEL), f32),
        'ffn_w_in': n(ks[8], (DEPTH, D_MODEL, 2 * FFN_HIDDEN), f32) * D_MODEL ** -0.5,
        'ffn_w_out': n(ks[9], (DEPTH, FFN_HIDDEN, D_MODEL), f32) * FFN_HIDDEN ** -0.5,
        'even_w_in': n(ks[10], (N_EVEN, D_MODEL, EVEN_IN), f32) * D_MODEL ** -0.5,
        'even_w_out': n(ks[11], (N_EVEN, EVEN_OUT, D_MODEL), f32) * EVEN_OUT ** -0.5,
        'sgu_w': n(ks[12], (N_EVEN, A_GROUPS, CHUNK, CHUNK), f32) * CHUNK ** -0.5,
        'sgu_b': 1.0 + 0.1 * n(ks[13], (N_EVEN, A_GROUPS, CHUNK), f32),
        'diff_lq1': 0.1 * n(ks[14], (N_EVEN, HEAD_DIM), f32),
        'diff_lk1': 0.1 * n(ks[15], (N_EVEN, HEAD_DIM), f32),
        'diff_lq2': 0.1 * n(ks[16], (N_EVEN, HEAD_DIM), f32),
        'diff_lk2': 0.1 * n(ks[17], (N_EVEN, HEAD_DIM), f32),
        'diff_subln_g': 1.0 + 0.02 * n(ks[18], (N_EVEN, B_V_DIM), f32),
        'odd_w_qkv': n(ks[19], (N_ODD, D_MODEL, C_IN), f32) * D_MODEL ** -0.5,
        'odd_w_out': n(ks[20], (N_ODD, C_Q_WIDTH, D_MODEL), f32) * C_Q_WIDTH ** -0.5,
        'odd_sink': 0.5 * n(ks[21], (N_ODD, C_HEADS), f32),
        'final_g': 1.0 + 0.02 * n(ks[22], (D_MODEL,), f32),
    }


def reference(x, c, ctx, c_ctx, ada_w, ada_b, norm1_g, norm2_g, ffn_w_in, ffn_w_out,
              even_w_in, even_w_out, sgu_w, sgu_b, diff_lq1, diff_lk1, diff_lq2, diff_lk2,
              diff_subln_g, odd_w_qkv, odd_w_out, odd_sink, final_g):
    s_len = x.shape[1]
    cos, sin = rope_tables(s_len, x.dtype)
    silu_c = jax.nn.silu(c)
    silu_cc = jax.nn.silu(c_ctx)
    h, hc = x, ctx
    for l in range(DEPTH):
        need_ctx = l < DEPTH - 1
        j = l // 2
        mod = silu_c @ ada_w[l] + ada_b[l]
        modc = silu_cc @ ada_w[l] + ada_b[l]
        sh1, sc1, g1, sh2, sc2, g2 = [m[:, None, :] for m in jnp.split(mod, 6, axis=-1)]
        csh1, csc1, cg1, csh2, csc2, cg2 = [m[None, None, :] for m in jnp.split(modc, 6, axis=-1)]
        a = modulate(h, norm1_g[l], sh1, sc1)
        ac = modulate(hc, norm1_g[l], csh1, csc1)
        if l % 2 == 0:
            lam_init = 0.8 - 0.6 * math.exp(-0.3 * l)
            y, yc = even_mixer(a, ac, even_w_in[j], even_w_out[j], sgu_w[j], sgu_b[j],
                               diff_lq1[j], diff_lk1[j], diff_lq2[j], diff_lk2[j], diff_subln_g[j],
                               lam_init, cos, sin, need_ctx)
        else:
            y, yc = odd_mixer(a, ac, odd_w_qkv[j], odd_w_out[j], odd_sink[j], cos, sin, need_ctx)
        h = h + g1 * y
        h = h + g2 * swiglu(modulate(h, norm2_g[l], sh2, sc2), ffn_w_in[l], ffn_w_out[l])
        if need_ctx:
            hc = hc + cg1 * yc
            hc = hc + cg2 * swiglu(modulate(hc, norm2_g[l], csh2, csc2), ffn_w_in[l], ffn_w_out[l])
    return rmsnorm(h, final_g)
```

```cpp
#include <hip/hip_runtime.h>
#include <hip/hip_cooperative_groups.h>
#include <cstdio>
#include <cstdint>
namespace cg = cooperative_groups;

#define LAS __attribute__((address_space(3)))
typedef unsigned short bf16_t;
typedef short bf16x8 __attribute__((ext_vector_type(8)));
typedef float f32x4 __attribute__((ext_vector_type(4)));
typedef float f32x2 __attribute__((ext_vector_type(2)));
typedef float f32x16 __attribute__((ext_vector_type(16)));
typedef unsigned u32x4 __attribute__((ext_vector_type(4)));
typedef unsigned u32x2 __attribute__((ext_vector_type(2)));
typedef __bf16 bf16v2 __attribute__((ext_vector_type(2)));

constexpr int DM = 1024, NB = 8, SEQ = 4096, NLAT = NB * SEQ, CTXL = 256, NCTX = NB * CTXL, MROWS = NLAT + NCTX;
constexpr int FFH = 2816, EVEN_IN = 2560, ODD_IN = 1536;
constexpr float EPS = 1e-6f;
constexpr float LOG2E = 1.4426950408889634f;
constexpr float QSCALE = 0.125f * LOG2E;
constexpr float NEGB = -1e30f;

constexpr size_t WS_WE_IN = 0;
constexpr size_t WS_WE_OUT = WS_WE_IN + (size_t)EVEN_IN * DM * 2;
constexpr size_t WS_WF_IN = WS_WE_OUT + (size_t)DM * DM * 2;
constexpr size_t WS_WF_OUT = WS_WF_IN + 2 * (size_t)(2 * FFH) * DM * 2;
constexpr size_t WS_WO_QKV = WS_WF_OUT + 2 * (size_t)DM * FFH * 2;
constexpr size_t WS_WO_OUT = WS_WO_QKV + (size_t)ODD_IN * DM * 2;
constexpr size_t WS_SGU = WS_WO_OUT + (size_t)DM * DM * 2;
constexpr size_t WS_MOD = WS_SGU + 4 * 128 * 128 * 2;
constexpr size_t WS_ROPE = WS_MOD + 2 * 9 * 6144 * 4;
constexpr size_t WS_HC = WS_ROPE + 8192;
constexpr size_t WS_A = WS_HC + (size_t)NCTX * DM * 4;
constexpr size_t WS_MIX = WS_A + (size_t)MROWS * DM * 2;
constexpr size_t WS_BIG = WS_MIX + (size_t)MROWS * DM * 2;
constexpr size_t WS_END = WS_BIG + (size_t)MROWS * FFH * 2;

constexpr int LDS_BYTES = 131072;

__device__ __forceinline__ unsigned pk2(float lo, float hi) { f32x2 v = {lo, hi}; bf16v2 b = __builtin_convertvector(v, bf16v2); return __builtin_bit_cast(unsigned, b); }
__device__ __forceinline__ float bf_lo(unsigned w) { return __uint_as_float(w << 16); }
__device__ __forceinline__ float bf_hi(unsigned w) { return __uint_as_float(w & 0xffff0000u); }
__device__ __forceinline__ float wave_sum(float v) {
#pragma unroll
    for (int o = 1; o < 64; o <<= 1) v += __shfl_xor(v, o);
    return v;
}
__device__ __forceinline__ float fexp2(float x) { return __builtin_amdgcn_exp2f(x); }

namespace pg8 {
#define PG8_LAS __attribute__((address_space(3)))
constexpr int BM = 256, BK = 64, HALF = 128, HTB = HALF * BK * 2, STAGE_BYTES = 8 * HTB, NXCD = 8, WGM = 8;
__host__ __device__ __forceinline__ int lds_byte(int r, int c) { const int st = (r >> 4) * 2 + (c >> 5), rr = r & 15, cc = c & 31, ob = rr * 64 + cc * 2; return st * 1024 + (ob ^ (((ob >> 9) & 1) << 5)); }
__host__ __device__ __forceinline__ void stage_rc(int b, int& R, int& C) { const int st = b / 1024, sb = b % 1024, swz = sb ^ (((sb >> 9) & 1) << 5); R = (st >> 1) * 16 + swz / 64; C = (st & 1) * 32 + (swz % 64) / 2; }
__host__ __device__ __forceinline__ int perm32(int rho) { const int n = rho >> 4, i = rho & 15; return 8 * (i >> 2) + 4 * n + (i & 3); }

struct Unit { int pm, pn; };
struct Gemm { const bf16_t* A; const bf16_t* Bt; int M, N, K; };

struct StaticOrder {
    int nM, nN, nwg, G, c;
    __host__ __device__ void init(int M, int N, int G_, int c_) { nM = M / BM; nN = N / BM; nwg = nM * nN; G = G_; c = c_; }
    __host__ __device__ bool next(int i, Unit& u) const {
        const long L = (long)i * G + c; if (L >= nwg) return false;
        int wgid = (int)L; { const int q = nwg / NXCD, r = nwg % NXCD, xcd = wgid % NXCD, off = wgid / NXCD; wgid = (xcd < r ? xcd * (q + 1) : r * (q + 1) + (xcd - r) * q) + off; }
        const int nig = WGM * nN, gid = wgid / nig, fm = gid * WGM, gsz = (nM - fm) < WGM ? (nM - fm) : WGM;
        u.pm = fm + ((wgid % nig) % gsz); u.pn = (wgid % nig) / gsz; return true;
    }
    __device__ __forceinline__ void a_ready(const Unit&) const {}
    __device__ __forceinline__ void done(const Unit&) const {}
};

__device__ __forceinline__ f32x2 gelu_pk(f32x2 v) {
    const f32x2 av = __builtin_elementwise_abs(v), d = av * 0.2316418882f + 1.0f;
    f32x2 t; t.x = __builtin_amdgcn_rcpf(d.x); t.y = __builtin_amdgcn_rcpf(d.y);
    f32x2 q = t * 0.5307027145f + (-0.7265760135f); q = q * t + 0.7107068705f; q = q * t + (-0.142248368f); q = q * t + 0.127414796f; q = q * t;
    const f32x2 s = (v * v) * (-0.72134752044f);
    f32x2 e; e.x = __builtin_amdgcn_exp2f(s.x); e.y = __builtin_amdgcn_exp2f(s.y);
    const f32x2 m = v * (q * e), r = v - m;
    f32x2 o; o.x = v.x < 0.f ? m.x : r.x; o.y = v.y < 0.f ? m.y : r.y; return o;
}
__device__ __forceinline__ f32x4 gelu4(f32x4 v) { f32x2 a = gelu_pk((f32x2){v[0], v[1]}), b = gelu_pk((f32x2){v[2], v[3]}); return (f32x4){a.x, a.y, b.x, b.y}; }


struct EpiQKV {
    static constexpr bool PERM = false, AFTER_DRAIN = false;
    bf16_t* O; int ldc, gelu_end, rope_lo, rope_hi, q_hi; const float* rope;
    __device__ __forceinline__ void operator()(const f32x4 (&acc)[2][2][4][2], const Unit& u, int wr, int wc, int fr, int fq) const {
#pragma unroll
        for (int ai = 0; ai < 2; ++ai)
#pragma unroll
            for (int m = 0; m < 4; ++m) {
                const int row = u.pm * BM + ai * HALF + wr * 64 + m * 16 + fr;
                const bool lat = row < NLAT; const int t = row & (SEQ - 1); const int pos = (wc & 1) ? (t & 63) : (t >> 6);
                bf16_t* rowp = O + (size_t)row * ldc + u.pn * BM + wc * 32 + 4 * fq;
#pragma unroll
                for (int bj = 0; bj < 2; ++bj) {
                    const int colb = u.pn * BM + bj * HALF;
                    f32x4 v0 = acc[ai][bj][m][0], v1 = acc[ai][bj][m][1];
                    if (colb < gelu_end) { v0 = gelu4(v0); v1 = gelu4(v1); }
                    else if (colb >= rope_lo && colb < rope_hi) {
                        if (lat) {
                            const f32x4 c4 = *(const f32x4*)(rope + pos * 16 + 4 * fq), s4 = *(const f32x4*)(rope + 1024 + pos * 16 + 4 * fq);
                            const f32x4 o0 = v0 * c4 - v1 * s4, o1 = v1 * c4 + v0 * s4; v0 = o0; v1 = o1;
                        }
                        if (colb < q_hi) { v0 = v0 * QSCALE; v1 = v1 * QSCALE; }
                    }
                    u32x2 w0, w1; w0.x = pk2(v0[0], v0[1]); w0.y = pk2(v0[2], v0[3]); w1.x = pk2(v1[0], v1[1]); w1.y = pk2(v1[2], v1[3]);
                    *(u32x2*)(rowp + bj * HALF) = w0; *(u32x2*)(rowp + bj * HALF + 16) = w1;
                }
            }
    }
};
struct EpiRes {
    static constexpr bool PERM = false, AFTER_DRAIN = false;
    const float* base_lat; const float* base_ctx; float* out_lat; float* out_ctx; const float* gate;
    __device__ __forceinline__ void operator()(const f32x4 (&acc)[2][2][4][2], const Unit& u, int wr, int wc, int fr, int fq) const {
#pragma unroll
        for (int ai = 0; ai < 2; ++ai)
#pragma unroll
            for (int m = 0; m < 4; ++m) {
                const int row = u.pm * BM + ai * HALF + wr * 64 + m * 16 + fr;
                const bool lat = row < NLAT; const int ridx = lat ? (row >> 12) : 8;
                const size_t roff = lat ? (size_t)row * DM : (size_t)(row - NLAT) * DM;
                const float* b = (lat ? base_lat : base_ctx) + roff; float* o = (lat ? out_lat : out_ctx) + roff;
                const float* gr = gate + ridx * 6144;
#pragma unroll
                for (int bj = 0; bj < 2; ++bj)
#pragma unroll
                    for (int n = 0; n < 2; ++n) {
                        const int col = u.pn * BM + bj * HALF + wc * 32 + n * 16 + 4 * fq;
                        const f32x4 bv = *(const f32x4*)(b + col), gv = *(const f32x4*)(gr + col);
                        *(f32x4*)(o + col) = bv + gv * acc[ai][bj][m][n];
                    }
            }
    }
};
struct EpiSwiglu {
    static constexpr bool PERM = true, AFTER_DRAIN = false;
    bf16_t* H;
    __device__ __forceinline__ void operator()(const f32x4 (&acc)[2][2][4][2], const Unit& u, int wr, int wc, int fr, int fq) const {
#pragma unroll
        for (int ai = 0; ai < 2; ++ai)
#pragma unroll
            for (int m = 0; m < 4; ++m) {
                const int row = u.pm * BM + ai * HALF + wr * 64 + m * 16 + fr;
                bf16_t* p = H + (size_t)row * FFH + u.pn * HALF + wc * 32 + 8 * fq;
                float r[8];
#pragma unroll
                for (int n = 0; n < 2; ++n)
#pragma unroll
                    for (int j = 0; j < 4; ++j) { const float g = acc[ai][0][m][n][j], uu = acc[ai][1][m][n][j];
                        r[4 * n + j] = g * __builtin_amdgcn_rcpf(1.0f + __builtin_amdgcn_exp2f(-g * LOG2E)) * uu; }
                u32x4 w; w.x = pk2(r[0], r[1]); w.y = pk2(r[2], r[3]); w.z = pk2(r[4], r[5]); w.w = pk2(r[6], r[7]);
                *(u32x4*)p = w;
            }
    }
};

template <class Epi, class Sched, bool ALIGN_EPI = false, bool SP2 = false>
__device__ __forceinline__ void gemm_phase(PG8_LAS unsigned char* lds, const Gemm g, const Sched& S, const Epi& E, const int tid) {
    const int wid = __builtin_amdgcn_readfirstlane(tid >> 6), lane = tid & 63, wr = wid >> 2, wc = wid & 3, fr = lane & 15, fq = lane >> 4;
    const int K = g.K, nt = K / BK;
    unsigned voffA[2], voffB[2];
#pragma unroll
    for (int i = 0; i < 2; ++i) { int R, C; stage_rc(tid * 16 + i * 8192, R, C); const int Rb = Epi::PERM ? ((R & ~31) + perm32(R & 31)) : R;
        voffA[i] = (unsigned)(R * K + C) * 2u; voffB[i] = (unsigned)(Rb * K + C) * 2u; }
    const size_t kstep = (size_t)(BK * 2);
    const size_t hstep = (size_t)HALF * K * 2;
    const size_t tstep = 2 * hstep;
    const unsigned ldsw = (unsigned)wid * 1024u;
    const int aoff = lds_byte(wr * 64 + fr, fq * 8), boff = lds_byte(wc * 32 + fr, fq * 8);
#define PG8_SA(b, h) (((b) * 2 + (h)) * HTB)
#define PG8_SB(b, h) ((4 + (b) * 2 + (h)) * HTB)
#define PG8_STAGE(bufoff, gbase, voff) do { _Pragma("unroll") for (int _i = 0; _i < 2; ++_i) \
        __builtin_amdgcn_global_load_lds((const unsigned*)((const char*)(gbase) + (voff)[_i]), (PG8_LAS unsigned*)(lds + (bufoff) + ldsw + _i * 8192), 16, 0, 0); } while (0)
#define PG8_LDA(dst, b, h) do { _Pragma("unroll") for (int m = 0; m < 4; ++m) _Pragma("unroll") for (int k = 0; k < 2; ++k) dst[m][k] = *(const PG8_LAS bf16x8*)(lds + PG8_SA(b, h) + aoff + m * 2048 + k * 1024); } while (0)
#define PG8_LDB(dst, b, h) do { _Pragma("unroll") for (int n = 0; n < 2; ++n) _Pragma("unroll") for (int k = 0; k < 2; ++k) dst[n][k] = *(const PG8_LAS bf16x8*)(lds + PG8_SB(b, h) + boff + n * 2048 + k * 1024); } while (0)
#define PG8_MMA(ai, bj, At, Bt) do { __builtin_amdgcn_s_setprio(1); _Pragma("unroll") for (int m = 0; m < 4; ++m) _Pragma("unroll") for (int n = 0; n < 2; ++n) _Pragma("unroll") for (int k = 0; k < 2; ++k) \
        acc[ai][bj][m][n] = __builtin_amdgcn_mfma_f32_16x16x32_bf16(Bt[n][k], At[m][k], acc[ai][bj][m][n], 0, 0, 0); __builtin_amdgcn_s_setprio(0); } while (0)
#define PG8_WAIT_V(n) asm volatile("s_waitcnt vmcnt(" #n ")" ::: "memory")
#define PG8_WAIT_L(n) asm volatile("s_waitcnt lgkmcnt(" #n ")" ::: "memory")
#define PG8_BAR __builtin_amdgcn_s_barrier()
#define PG8_SCHED __builtin_amdgcn_sched_barrier(0)
    Unit cur, nxt; int ui = 0;
    if (!S.next(0, cur)) return;
    f32x4 acc[2][2][4][2];
#pragma unroll
    for (int a = 0; a < 2; ++a)
#pragma unroll
        for (int b = 0; b < 2; ++b)
#pragma unroll
            for (int m = 0; m < 4; ++m)
#pragma unroll
                for (int n = 0; n < 2; ++n) acc[a][b][m][n] = (f32x4){0.f, 0.f, 0.f, 0.f};
    bf16x8 At[4][2], B0[2][2], B1[2][2];
    const char* cA = (const char*)g.A + (size_t)cur.pm * tstep; const char* cB = (const char*)g.Bt + (size_t)cur.pn * tstep;
    S.a_ready(cur);
    if constexpr (SP2) {
        PG8_STAGE(PG8_SB(0, 0), cB, voffB); PG8_STAGE(PG8_SB(0, 1), cB + hstep, voffB); PG8_STAGE(PG8_SA(0, 0), cA, voffA); PG8_STAGE(PG8_SA(0, 1), cA + hstep, voffA);
        if (wr == 1) PG8_BAR;
        PG8_WAIT_V(2); PG8_BAR;
        PG8_STAGE(PG8_SB(1, 0), cB + kstep, voffB); PG8_STAGE(PG8_SA(1, 0), cA + kstep, voffA); PG8_STAGE(PG8_SB(1, 1), cB + hstep + kstep, voffB);
        PG8_WAIT_V(6); PG8_BAR;
    } else {
        PG8_STAGE(PG8_SB(0, 0), cB, voffB); PG8_STAGE(PG8_SA(0, 0), cA, voffA); PG8_STAGE(PG8_SB(0, 1), cB + hstep, voffB); PG8_STAGE(PG8_SA(0, 1), cA + hstep, voffA);
        if (wr == 1) PG8_BAR;
        PG8_WAIT_V(4); PG8_BAR;
        PG8_STAGE(PG8_SB(1, 0), cB + kstep, voffB); PG8_STAGE(PG8_SA(1, 0), cA + kstep, voffA); PG8_STAGE(PG8_SB(1, 1), cB + hstep + kstep, voffB);
        PG8_WAIT_V(6); PG8_BAR;
    }
    for (;;) {
        const bool has_next = S.next(ui + 1, nxt);
        const char* nA = has_next ? (const char*)g.A + (size_t)nxt.pm * tstep : cA; const char* nB = has_next ? (const char*)g.Bt + (size_t)nxt.pn * tstep : cB;
        for (int t = 0; t < nt; t += 2) {
            const bool last = (t == nt - 2);
            const char* a1 = cA + (size_t)(t + 1) * kstep;
            const char* a2 = last ? nA : cA + (size_t)(t + 2) * kstep; const char* b2 = last ? nB : cB + (size_t)(t + 2) * kstep;
            const char* a3 = a2 + kstep; const char* b3 = b2 + kstep;
            if (last && has_next) S.a_ready(nxt);
            if constexpr (SP2) {
            PG8_LDB(B0, 0, 0); PG8_LDB(B1, 0, 1); PG8_SCHED; PG8_LDA(At, 0, 0); PG8_STAGE(PG8_SA(1, 1), a1 + hstep, voffA);
            PG8_WAIT_V(8); PG8_WAIT_L(0); PG8_BAR; PG8_MMA(0, 0, At, B0); PG8_MMA(0, 1, At, B1); PG8_BAR; PG8_SCHED;
            PG8_LDA(At, 0, 1); PG8_STAGE(PG8_SB(0, 0), b2, voffB); PG8_STAGE(PG8_SB(0, 1), b2 + hstep, voffB); PG8_STAGE(PG8_SA(0, 0), a2, voffA);
            PG8_WAIT_V(8); PG8_WAIT_L(0); PG8_BAR; PG8_MMA(1, 0, At, B0); PG8_MMA(1, 1, At, B1); PG8_BAR; PG8_SCHED;
            PG8_LDB(B0, 1, 0); PG8_LDB(B1, 1, 1); PG8_SCHED; PG8_LDA(At, 1, 0); PG8_STAGE(PG8_SA(0, 1), a2 + hstep, voffA);
            PG8_WAIT_V(8); PG8_WAIT_L(0); PG8_BAR; PG8_MMA(0, 0, At, B0); PG8_MMA(0, 1, At, B1); PG8_BAR; PG8_SCHED;
            PG8_LDA(At, 1, 1); PG8_STAGE(PG8_SB(1, 0), b3, voffB); PG8_STAGE(PG8_SB(1, 1), b3 + hstep, voffB); PG8_STAGE(PG8_SA(1, 0), a3, voffA);
            PG8_WAIT_V(8); PG8_WAIT_L(0); PG8_BAR; PG8_MMA(1, 0, At, B0); PG8_MMA(1, 1, At, B1); PG8_BAR; PG8_SCHED;
            } else {
            PG8_LDB(B0, 0, 0); PG8_SCHED; PG8_LDA(At, 0, 0); PG8_STAGE(PG8_SA(1, 1), a1 + hstep, voffA);
            PG8_WAIT_L(8); PG8_BAR; PG8_WAIT_L(0); PG8_MMA(0, 0, At, B0); PG8_BAR; PG8_SCHED;
            PG8_LDB(B1, 0, 1); PG8_STAGE(PG8_SB(0, 0), b2, voffB);
            PG8_BAR; PG8_WAIT_L(0); PG8_MMA(0, 1, At, B1); PG8_BAR;
            PG8_LDA(At, 0, 1); PG8_STAGE(PG8_SA(0, 0), a2, voffA);
            PG8_BAR; PG8_WAIT_L(0); PG8_MMA(1, 0, At, B0); PG8_BAR; PG8_SCHED;
            PG8_STAGE(PG8_SB(0, 1), b2 + hstep, voffB);
            PG8_WAIT_V(6); PG8_BAR; PG8_MMA(1, 1, At, B1); PG8_BAR;
            PG8_LDB(B0, 1, 0); PG8_SCHED; PG8_LDA(At, 1, 0); PG8_STAGE(PG8_SA(0, 1), a2 + hstep, voffA);
            PG8_WAIT_L(8); PG8_BAR; PG8_WAIT_L(0); PG8_MMA(0, 0, At, B0); PG8_BAR; PG8_SCHED;
            PG8_LDB(B1, 1, 1); PG8_STAGE(PG8_SB(1, 0), b3, voffB);
            PG8_BAR; PG8_WAIT_L(0); PG8_MMA(0, 1, At, B1); PG8_BAR;
            PG8_LDA(At, 1, 1); PG8_STAGE(PG8_SA(1, 0), a3, voffA);
            PG8_BAR; PG8_WAIT_L(0); PG8_MMA(1, 0, At, B0); PG8_BAR; PG8_SCHED;
            PG8_STAGE(PG8_SB(1, 1), b3 + hstep, voffB);
            PG8_WAIT_V(6); PG8_BAR; PG8_MMA(1, 1, At, B1); PG8_BAR;
            }
        }
        if constexpr (ALIGN_EPI) { if (wr == 0) PG8_BAR; }
        if constexpr (!Epi::AFTER_DRAIN) { E(acc, cur, wr, wc, fr, fq); S.done(cur); }
        if (!has_next) break;
#pragma unroll
        for (int a = 0; a < 2; ++a)
#pragma unroll
            for (int b = 0; b < 2; ++b)
#pragma unroll
                for (int m = 0; m < 4; ++m)
#pragma unroll
                    for (int n = 0; n < 2; ++n) acc[a][b][m][n] = (f32x4){0.f, 0.f, 0.f, 0.f};
        cur = nxt; cA = nA; cB = nB; ++ui;
        if constexpr (ALIGN_EPI) { if (wr == 1) PG8_BAR; }
    }
    PG8_WAIT_V(0);
    if constexpr (!ALIGN_EPI) { if (wr == 0) PG8_BAR; }
    PG8_BAR;
#undef PG8_SA
#undef PG8_SB
#undef PG8_STAGE
#undef PG8_LDA
#undef PG8_LDB
#undef PG8_MMA
#undef PG8_WAIT_V
#undef PG8_WAIT_L
#undef PG8_BAR
#undef PG8_SCHED
}
}

__device__ __forceinline__ void transpose_item(const float* __restrict__ W, int K, int N, bf16_t* WT, int drow0, int k0, int n0, LAS float* scr, int lane) {
#pragma unroll 8
    for (int i = 0; i < 32; ++i) { const int kk = 2 * i + (lane >> 5); scr[kk * 33 + (lane & 31)] = W[(size_t)(k0 + kk) * N + n0 + (lane & 31)]; }
    asm volatile("s_waitcnt lgkmcnt(0)" ::: "memory");
    const int c = lane & 7;
#pragma unroll
    for (int j = 0; j < 4; ++j) { const int n = (lane >> 3) + 8 * j; const LAS float* s = scr + (8 * c) * 33 + n;
        u32x4 o; o.x = pk2(s[0 * 33], s[1 * 33]); o.y = pk2(s[2 * 33], s[3 * 33]); o.z = pk2(s[4 * 33], s[5 * 33]); o.w = pk2(s[6 * 33], s[7 * 33]);
        *(u32x4*)(WT + (size_t)(drow0 + n) * K + k0 + 8 * c) = o; }
    asm volatile("s_waitcnt lgkmcnt(0)" ::: "memory");
}
template <bool FFN_IN>
__device__ __forceinline__ void transpose_mat(const float* W, int K, int N, bf16_t* WT, int item, LAS float* scr, int lane) {
    const int nblk = N / 32, kb = item / nblk, nb = item % nblk, n0 = nb * 32;
    int drow0 = n0;
    if (FFN_IN) { const int hf = n0 >= FFH ? 1 : 0; const int j = n0 - hf * FFH; drow0 = 256 * (j >> 7) + 128 * hf + (j & 127); }
    transpose_item(W, K, N, WT, drow0, kb * 64, n0, scr, lane);
}

#define MFMA32(a, b, c) __builtin_amdgcn_mfma_f32_32x32x16_bf16((a), (b), (c), 0, 0, 0)
__device__ __forceinline__ int keypos(int key) { return (key & ~12) | ((key & 4) << 1) | ((key & 8) >> 1); }

template <int EB, bool MASKED>
__device__ __forceinline__ void flash_tile(const LAS unsigned char* kb, const int kstr, const LAS unsigned char* vt, const bf16x8 (&qf)[4], f32x16 (&O)[EB],
                                           float& m, float& lsum, const int l32, const int half, const int qpos, const int kpos0) {
    f32x16 s0, s1;
#pragma unroll
    for (int i = 0; i < 16; ++i) { s0[i] = 0.f; s1[i] = 0.f; }
#pragma unroll
    for (int ks = 0; ks < 4; ++ks) {
        const bf16x8 a0 = *(const LAS bf16x8*)(kb + l32 * kstr + ks * 32 + half * 16);
        const bf16x8 a1 = *(const LAS bf16x8*)(kb + (32 + l32) * kstr + ks * 32 + half * 16);
        s0 = MFMA32(a0, qf[ks], s0); s1 = MFMA32(a1, qf[ks], s1);
    }
    if (MASKED) {
#pragma unroll
        for (int i = 0; i < 16; ++i) {
            const int kp = kpos0 + (i & 3) + 8 * (i >> 2) + 4 * half; const int d0 = qpos - kp, d1 = d0 - 32;
            if (d0 > 128 || d0 < -128) s0[i] = NEGB;
            if (d1 > 128 || d1 < -128) s1[i] = NEGB;
        }
    }
    float mx = fmaxf(s0[0], s1[0]);
#pragma unroll
    for (int i = 1; i < 16; ++i) mx = fmaxf(mx, fmaxf(s0[i], s1[i]));
    mx = fmaxf(mx, __shfl_xor(mx, 32));
    const float mn = fmaxf(m, mx); const float alpha = fexp2(m - mn); m = mn;
    float ps = 0.f;
#pragma unroll
    for (int i = 0; i < 16; ++i) { s0[i] = fexp2(s0[i] - mn); s1[i] = fexp2(s1[i] - mn); ps += s0[i] + s1[i]; }
    lsum = lsum * alpha + ps;
#pragma unroll
    for (int eb = 0; eb < EB; ++eb) O[eb] = O[eb] * alpha;
#pragma unroll
    for (int st = 0; st < 2; ++st) {
        u32x4 p; p.x = pk2(s0[8 * st + 0], s0[8 * st + 1]); p.y = pk2(s0[8 * st + 2], s0[8 * st + 3]); p.z = pk2(s0[8 * st + 4], s0[8 * st + 5]); p.w = pk2(s0[8 * st + 6], s0[8 * st + 7]);
        const bf16x8 pf = __builtin_bit_cast(bf16x8, p);
#pragma unroll
        for (int eb = 0; eb < EB; ++eb) { const bf16x8 vf = *(const LAS bf16x8*)(vt + (32 * eb + l32) * 144 + (st * 16 + 8 * half) * 2); O[eb] = MFMA32(vf, pf, O[eb]); }
    }
#pragma unroll
    for (int st = 0; st < 2; ++st) {
        u32x4 p; p.x = pk2(s1[8 * st + 0], s1[8 * st + 1]); p.y = pk2(s1[8 * st + 2], s1[8 * st + 3]); p.z = pk2(s1[8 * st + 4], s1[8 * st + 5]); p.w = pk2(s1[8 * st + 6], s1[8 * st + 7]);
        const bf16x8 pf = __builtin_bit_cast(bf16x8, p);
#pragma unroll
        for (int eb = 0; eb < EB; ++eb) { const bf16x8 vf = *(const LAS bf16x8*)(vt + (32 * eb + l32) * 144 + ((2 + st) * 16 + 8 * half) * 2); O[eb] = MFMA32(vf, pf, O[eb]); }
    }
}

__device__ __forceinline__ void vt_scatter(LAS unsigned char* vt, const u32x4 v, const int e0, const int key) {
    const int kp2 = keypos(key) * 2;
#pragma unroll
    for (int t = 0; t < 4; ++t) {
        *(LAS unsigned short*)(vt + (e0 + 2 * t) * 144 + kp2) = (unsigned short)(v[t] & 0xffffu);
        *(LAS unsigned short*)(vt + (e0 + 2 * t + 1) * 144 + kp2) = (unsigned short)(v[t] >> 16);
    }
}

constexpr int DA_KSTR = 272, DA_KB = 64 * DA_KSTR  , DA_VT = 128 * 144  ;
__device__ __forceinline__ void diff_attn_unit(LAS unsigned char* lds, const bf16_t* __restrict__ P1, bf16_t* __restrict__ MIX, const float* __restrict__ subln_g,
                                               const float lam, const float one_m_li, const int qrow0, const int h, const int krow_lat0, const int nlat, const int krow_ctx0, const int nt,
                                               const int tid, const int wave, const int lane) {
    const int l32 = lane & 31, half = lane >> 5;
    LAS unsigned char* KB[2] = {lds, lds + DA_KB};
    LAS unsigned char* VT[2] = {lds + 2 * DA_KB, lds + 2 * DA_KB + DA_VT};
    const int sj = wave & 1, qblk = wave >> 1;
    const int qrow = qrow0 + 32 * qblk + l32;
    bf16x8 qf[4];
    { const bf16_t* qp = P1 + (size_t)qrow * EVEN_IN + 1024 + h * 128 + sj * 64 + 8 * half;
#pragma unroll
      for (int ks = 0; ks < 4; ++ks) qf[ks] = *(const bf16x8*)(qp + 16 * ks); }
    f32x16 O[4];
#pragma unroll
    for (int eb = 0; eb < 4; ++eb)
#pragma unroll
        for (int i = 0; i < 16; ++i) O[eb][i] = 0.f;
    float m = NEGB, l = 0.f;
    const int skey = tid >> 4, sch = tid & 15;
    u32x4 kreg[2], vreg[2];
#define DA_LOAD(t) do { const int kr_ = ((t) < nlat) ? krow_lat0 + 64 * (t) : krow_ctx0 + 64 * ((t) - nlat); \
        _Pragma("unroll") for (int i_ = 0; i_ < 2; ++i_) { const bf16_t* rp_ = P1 + (size_t)(kr_ + skey + 32 * i_) * EVEN_IN + h * 128 + sch * 8; \
            kreg[i_] = *(const u32x4*)(rp_ + 1536); vreg[i_] = *(const u32x4*)(rp_ + 2048); } } while (0)
#define DA_STORE(buf) do { _Pragma("unroll") for (int i_ = 0; i_ < 2; ++i_) { const int key_ = skey + 32 * i_; \
        *(LAS u32x4*)(KB[buf] + key_ * DA_KSTR + sch * 16) = kreg[i_]; vt_scatter(VT[buf], vreg[i_], 8 * sch, key_); } } while (0)
    DA_LOAD(0); DA_STORE(0);
    __syncthreads();
    for (int t = 0; t < nt; ++t) {
        const int cur = t & 1;
        if (t + 1 < nt) DA_LOAD(t + 1);
        flash_tile<4, false>(KB[cur] + sj * 128, DA_KSTR, VT[cur], qf, O, m, l, l32, half, 0, 0);
        if (t + 1 < nt) { if (cur == 0) DA_STORE(1); else DA_STORE(0); }
        __syncthreads();
    }
#undef DA_LOAD
#undef DA_STORE
    l += __shfl_xor(l, 32);
    LAS float* xch = (LAS float*)lds + qblk * 4096 + lane;
    if (sj == 1) {
        const float i1 = lam / l;
#pragma unroll
        for (int eb = 0; eb < 4; ++eb)
#pragma unroll
            for (int i = 0; i < 16; ++i) xch[(eb * 16 + i) * 64] = O[eb][i] * i1;
    }
    __syncthreads();
    if (sj == 0) {
        const float i0 = 1.0f / l;
        float ss = 0.f;
#pragma unroll
        for (int eb = 0; eb < 4; ++eb)
#pragma unroll
            for (int i = 0; i < 16; ++i) { const float o = O[eb][i] * i0 - xch[(eb * 16 + i) * 64]; O[eb][i] = o; ss += o * o; }
        ss += __shfl_xor(ss, 32);
        const float r = one_m_li / sqrtf(ss * (1.0f / 128.0f) + EPS);
        bf16_t* op = MIX + (size_t)qrow * DM + 512 + h * 128 + 4 * half;
#pragma unroll
        for (int eb = 0; eb < 4; ++eb)
#pragma unroll
            for (int gi = 0; gi < 4; ++gi) {
                const int e0 = 32 * eb + 8 * gi;
                const f32x4 g4 = *(const f32x4*)(subln_g + e0 + 4 * half);
                u32x2 w; w.x = pk2(O[eb][4 * gi] * r * g4[0], O[eb][4 * gi + 1] * r * g4[1]); w.y = pk2(O[eb][4 * gi + 2] * r * g4[2], O[eb][4 * gi + 3] * r * g4[3]);
                *(u32x2*)(op + e0) = w;
            }
    }
    __syncthreads();
}

constexpr int WA_KB = 64 * 144  ;
__device__ __forceinline__ void win_attn_unit(LAS unsigned char* lds, const bf16_t* __restrict__ QKV, bf16_t* __restrict__ MIX, const float* __restrict__ sink,
                                              const int b, const int kvh, const int start, const int tid, const int wave, const int lane) {
    const int l32 = lane & 31, half = lane >> 5;
    LAS unsigned char* KB[2] = {lds, lds + WA_KB};
    LAS unsigned char* VT[2] = {lds + 2 * WA_KB, lds + 3 * WA_KB};
    const int head = kvh * 4 + (wave >> 1);
    const int qpos = start + (wave & 1) * 32 + l32;
    bf16x8 qf[4];
    { const bf16_t* qp = QKV + (size_t)(b * SEQ + qpos) * ODD_IN + head * 64 + 8 * half;
#pragma unroll
      for (int ks = 0; ks < 4; ++ks) qf[ks] = *(const bf16x8*)(qp + 16 * ks); }
    f32x16 O[2];
#pragma unroll
    for (int eb = 0; eb < 2; ++eb)
#pragma unroll
        for (int i = 0; i < 16; ++i) O[eb][i] = 0.f;
    float m = NEGB, l = 0.f;
    const int t_lo = start >= 128 ? 0 : (128 - start) >> 6;
    const int t_hi = min(5, (SEQ + 128 - start) >> 6);
    const int nbd = t_hi - t_lo, nt = nbd + 4;
    const int skey = tid >> 3, sch = tid & 7;
    u32x4 kreg, vreg;
#define WA_LOAD(n) do { const int kr_ = ((n) < nbd) ? b * SEQ + start - 128 + 64 * (t_lo + (n)) : NLAT + b * CTXL + 64 * ((n) - nbd); \
        const bf16_t* rp_ = QKV + (size_t)(kr_ + skey) * ODD_IN + kvh * 64 + sch * 8; kreg = *(const u32x4*)(rp_ + 1024); vreg = *(const u32x4*)(rp_ + 1280); } while (0)
#define WA_STORE(buf) do { *(LAS u32x4*)(KB[buf] + skey * 144 + sch * 16) = kreg; vt_scatter(VT[buf], vreg, 8 * sch, skey); } while (0)
    WA_LOAD(0); WA_STORE(0);
    __syncthreads();
    for (int n = 0; n < nt; ++n) {
        const int cur = n & 1;
        if (n + 1 < nt) WA_LOAD(n + 1);
        if (n < nbd) flash_tile<2, true>(KB[cur], 144, VT[cur], qf, O, m, l, l32, half, qpos, start - 128 + 64 * (t_lo + n));
        else flash_tile<2, false>(KB[cur], 144, VT[cur], qf, O, m, l, l32, half, 0, 0);
        if (n + 1 < nt) { if (cur == 0) WA_STORE(1); else WA_STORE(0); }
        __syncthreads();
    }
#undef WA_LOAD
#undef WA_STORE
    const float sk2 = sink[head] * LOG2E;
    l += __shfl_xor(l, 32);
    float sc;
    { const float mn = fmaxf(m, sk2), al = fexp2(m - mn); sc = al / (l * al + fexp2(sk2 - mn)); }
    bf16_t* op = MIX + (size_t)(b * SEQ + qpos) * DM + head * 64 + 4 * half;
#pragma unroll
    for (int eb = 0; eb < 2; ++eb)
#pragma unroll
        for (int gi = 0; gi < 4; ++gi) {
            const int e0 = 32 * eb + 8 * gi;
            u32x2 w; w.x = pk2(O[eb][4 * gi] * sc, O[eb][4 * gi + 1] * sc); w.y = pk2(O[eb][4 * gi + 2] * sc, O[eb][4 * gi + 3] * sc);
            *(u32x2*)(op + e0) = w;
        }
}

__device__ __forceinline__ void chunk_mlp_unit(LAS unsigned char* lds, const bf16_t* __restrict__ P1, const bf16_t* __restrict__ Wsg, const float* __restrict__ sgu_b,
                                               bf16_t* __restrict__ MIX, const int rb, const int g, const int tid, const int wave, const int lane) {
    const int l32 = lane & 31, half = lane >> 5;
    const int rowbase = rb * 128;
#pragma unroll
    for (int pass = 0; pass < 4; ++pass) {
        const int q = pass * 32 + (tid >> 4), ch = tid & 15;
        const u32x4 raw = *(const u32x4*)(P1 + (size_t)(rowbase + q) * EVEN_IN + 512 + g * 128 + ch * 8);
        float x[8];
#pragma unroll
        for (int k = 0; k < 4; ++k) { x[2 * k] = bf_lo(raw[k]); x[2 * k + 1] = bf_hi(raw[k]); }
        float s = 0.f;
#pragma unroll
        for (int k = 0; k < 8; ++k) s += x[k];
        s += __shfl_xor(s, 1); s += __shfl_xor(s, 2); s += __shfl_xor(s, 4); s += __shfl_xor(s, 8);
        const float mu = s * (1.0f / 128.0f);
        float v = 0.f;
#pragma unroll
        for (int k = 0; k < 8; ++k) { x[k] -= mu; v += x[k] * x[k]; }
        v += __shfl_xor(v, 1); v += __shfl_xor(v, 2); v += __shfl_xor(v, 4); v += __shfl_xor(v, 8);
        const float rstd = 1.0f / sqrtf(v * (1.0f / 128.0f) + EPS);
#pragma unroll
        for (int k = 0; k < 4; ++k) { const unsigned w = pk2(x[2 * k] * rstd, x[2 * k + 1] * rstd);
            *(LAS unsigned short*)(lds + (8 * ch + 2 * k) * 272 + q * 2) = (unsigned short)(w & 0xffffu);
            *(LAS unsigned short*)(lds + (8 * ch + 2 * k + 1) * 272 + q * 2) = (unsigned short)(w >> 16); }
    }
    __syncthreads();
    const int pb = wave >> 1, cb0 = (wave & 1) * 2;
    f32x16 a0, a1;
#pragma unroll
    for (int i = 0; i < 16; ++i) { a0[i] = 0.f; a1[i] = 0.f; }
    const bf16_t* wp = Wsg + (size_t)(g * 128 + 32 * pb + l32) * 128 + 8 * half;
#pragma unroll
    for (int ks = 0; ks < 8; ++ks) {
        const bf16x8 a = *(const bf16x8*)(wp + 16 * ks);
        const bf16x8 b0 = *(const LAS bf16x8*)(lds + (32 * cb0 + l32) * 272 + (16 * ks + 8 * half) * 2);
        const bf16x8 b1 = *(const LAS bf16x8*)(lds + (32 * (cb0 + 1) + l32) * 272 + (16 * ks + 8 * half) * 2);
        a0 = MFMA32(a, b0, a0); a1 = MFMA32(a, b1, a1);
    }
#pragma unroll
    for (int i = 0; i < 16; ++i) {
        const int p = 32 * pb + (i & 3) + 8 * (i >> 2) + 4 * half;
        const float bias = sgu_b[g * 128 + p];
        const size_t row = (size_t)(rowbase + p);
        const int c0 = g * 128 + 32 * cb0 + l32;
        const float u0 = __uint_as_float((unsigned)P1[row * EVEN_IN + c0] << 16), u1 = __uint_as_float((unsigned)P1[row * EVEN_IN + c0 + 32] << 16);
        MIX[row * DM + c0] = (bf16_t)(pk2(u0 * (a0[i] + bias), 0.f) & 0xffffu);
        MIX[row * DM + c0 + 32] = (bf16_t)(pk2(u1 * (a1[i] + bias), 0.f) & 0xffffu);
    }
    __syncthreads();
}

__device__ __forceinline__ void norm_rows(const float* __restrict__ lat, const float* __restrict__ ctxp, const float* __restrict__ g, const float* __restrict__ modl,
                                          const int sh_off, const int sc_off, bf16_t* __restrict__ dst, const int nrows, const int gw, const int ngw, const int lane) {
    for (int row = gw; row < nrows; row += ngw) {
        const bool isl = row < NLAT;
        const float* src = isl ? lat + (size_t)row * DM : ctxp + (size_t)(row - NLAT) * DM;
        const float* mrow = modl + (isl ? (row >> 12) : 8) * 6144;
        const f32x4* xr = (const f32x4*)src + lane;
        f32x4 v[4]; float ss = 0.f;
#pragma unroll
        for (int j = 0; j < 4; ++j) { v[j] = xr[64 * j]; ss += (v[j][0] * v[j][0] + v[j][1] * v[j][1]) + (v[j][2] * v[j][2] + v[j][3] * v[j][3]); }
        const float rstd = 1.0f / sqrtf(wave_sum(ss) * (1.0f / DM) + EPS);
        u32x2* o8 = (u32x2*)(dst + (size_t)row * DM) + lane;
#pragma unroll
        for (int j = 0; j < 4; ++j) {
            const int col = 4 * lane + 256 * j;
            const f32x4 gg = *(const f32x4*)(g + col), sc = *(const f32x4*)(mrow + sc_off + col), sh = *(const f32x4*)(mrow + sh_off + col);
            const f32x4 o = v[j] * rstd * gg * (sc + 1.0f) + sh;
            u32x2 w; w.x = pk2(o[0], o[1]); w.y = pk2(o[2], o[3]); o8[64 * j] = w;
        }
    }
}

struct Params { const float* in[23]; float* out; unsigned char* ws; int ph_lo, ph_hi; };
enum { I_X = 0, I_C, I_CTX, I_CCTX, I_ADA_W, I_ADA_B, I_N1G, I_N2G, I_FFN_IN, I_FFN_OUT, I_EV_IN, I_EV_OUT, I_SGU_W, I_SGU_B, I_LQ1, I_LK1, I_LQ2, I_LK2, I_SUBLN, I_OD_QKV, I_OD_OUT, I_SINK, I_FINAL_G };
constexpr int NPHASE = 16;
#ifdef ONLY_PH
#define PH_ON(k) ((ONLY_PH) == (k))
#else
#define PH_ON(k) true
#endif

__global__ void __launch_bounds__(512, 2) mega_fwd(Params P) {
    extern __shared__ __attribute__((aligned(16))) unsigned char lds_raw[];
    LAS unsigned char* lds = (LAS unsigned char*)lds_raw;
    cg::grid_group grid = cg::this_grid();
    const int G = gridDim.x, bid = blockIdx.x;
    unsigned char* ws = P.ws;
    bf16_t* WE_IN = (bf16_t*)(ws + WS_WE_IN); bf16_t* WE_OUT = (bf16_t*)(ws + WS_WE_OUT); bf16_t* WF_IN = (bf16_t*)(ws + WS_WF_IN); bf16_t* WF_OUT = (bf16_t*)(ws + WS_WF_OUT);
    bf16_t* WO_QKV = (bf16_t*)(ws + WS_WO_QKV); bf16_t* WO_OUT = (bf16_t*)(ws + WS_WO_OUT); bf16_t* SGU = (bf16_t*)(ws + WS_SGU);
    float* MOD = (float*)(ws + WS_MOD); float* ROPE = (float*)(ws + WS_ROPE); float* HC = (float*)(ws + WS_HC);
    bf16_t* ABUF = (bf16_t*)(ws + WS_A); bf16_t* MIX = (bf16_t*)(ws + WS_MIX); bf16_t* BIG = (bf16_t*)(ws + WS_BIG);
    const float* X = P.in[I_X]; const float* CTX = P.in[I_CTX]; float* OUT = P.out;

    for (int ph = P.ph_lo; ph < P.ph_hi; ++ph) {
        int tid = threadIdx.x; asm volatile("" : "+v"(tid));
        const int lane = tid & 63, wave = __builtin_amdgcn_readfirstlane(tid >> 6);
        const int gw = bid * 8 + wave, ngw = G * 8;
        if (ph == 0 && PH_ON(0)) {
            LAS float* scr = (LAS float*)lds; LAS float* red = (LAS float*)(lds + 9 * 1024 * 4);
            for (int it = bid; it < 192; it += G) {
                const int l = it / 96, n0 = (it % 96) * 64;
                for (int idx = tid; idx < 9216; idx += 512) { const int r = idx >> 10, k = idx & 1023; const float cv = r < 8 ? P.in[I_C][r * 1024 + k] : P.in[I_CCTX][k];
                    scr[idx] = cv / (1.0f + __expf(-cv)); }
                __syncthreads();
                float acc[9];
#pragma unroll
                for (int r = 0; r < 9; ++r) acc[r] = 0.f;
                const float* Wp = P.in[I_ADA_W] + (size_t)l * 1024 * 6144 + (size_t)(wave * 128) * 6144 + n0 + lane;
#pragma unroll 4
                for (int kk = 0; kk < 128; ++kk) { const float wv = Wp[(size_t)kk * 6144];
#pragma unroll
                    for (int r = 0; r < 9; ++r) acc[r] += scr[r * 1024 + wave * 128 + kk] * wv; }
#pragma unroll
                for (int r = 0; r < 9; ++r) red[(wave * 9 + r) * 64 + lane] = acc[r];
                __syncthreads();
                for (int idx = tid; idx < 576; idx += 512) { const int r = idx >> 6, cc = idx & 63; float s = 0.f;
#pragma unroll
                    for (int w = 0; w < 8; ++w) s += red[(w * 9 + r) * 64 + cc];
                    MOD[(size_t)(l * 9 + r) * 6144 + n0 + cc] = s + P.in[I_ADA_B][l * 6144 + n0 + cc]; }
                __syncthreads();
            }
            for (int idx = bid * 512 + tid; idx < 1024; idx += G * 512) { const int pos = idx >> 4, i = idx & 15;
                const float inv = fexp2(-(float)i * (13.287712379549449f / 16.0f)); const float rev = (float)pos * inv * 0.15915494309189535f;
                ROPE[idx] = __builtin_amdgcn_cosf(rev); ROPE[1024 + idx] = __builtin_amdgcn_sinf(rev); }
            for (int idx = bid * 512 + tid; idx < 4 * 128 * 128 / 2; idx += G * 512) { const f32x2 v = *(const f32x2*)(P.in[I_SGU_W] + 2 * idx); ((unsigned*)SGU)[idx] = pk2(v.x, v.y); }
            LAS float* tscr = (LAS float*)(lds + wave * 8448);
            constexpr int T0 = 16 * 80, T1 = 16 * 32, T2 = 16 * 176, T3 = 44 * 32, T4 = 16 * 48, T5 = 16 * 32;
            constexpr int NIT = T0 + T1 + 2 * T2 + 2 * T3 + T4 + T5;
            for (int it = gw; it < NIT; it += ngw) {
                int r = it;
                if (r < T0) { transpose_mat<false>(P.in[I_EV_IN], DM, EVEN_IN, WE_IN, r, tscr, lane); continue; } r -= T0;
                if (r < T1) { transpose_mat<false>(P.in[I_EV_OUT], DM, DM, WE_OUT, r, tscr, lane); continue; } r -= T1;
                if (r < T2) { transpose_mat<true>(P.in[I_FFN_IN], DM, 2 * FFH, WF_IN, r, tscr, lane); continue; } r -= T2;
                if (r < T2) { transpose_mat<true>(P.in[I_FFN_IN] + (size_t)DM * 2 * FFH, DM, 2 * FFH, WF_IN + (size_t)2 * FFH * DM, r, tscr, lane); continue; } r -= T2;
                if (r < T3) { transpose_mat<false>(P.in[I_FFN_OUT], FFH, DM, WF_OUT, r, tscr, lane); continue; } r -= T3;
                if (r < T3) { transpose_mat<false>(P.in[I_FFN_OUT] + (size_t)FFH * DM, FFH, DM, WF_OUT + (size_t)DM * FFH, r, tscr, lane); continue; } r -= T3;
                if (r < T4) { transpose_mat<false>(P.in[I_OD_QKV], DM, ODD_IN, WO_QKV, r, tscr, lane); continue; } r -= T4;
                transpose_mat<false>(P.in[I_OD_OUT], DM, DM, WO_OUT, r, tscr, lane);
            }
        } else if ((ph == 1 || ph == 5 || ph == 8 || ph == 12) && PH_ON(1)) {
            const int l = ph >= 8 ? 1 : 0; const bool first = (ph == 1 || ph == 8);
            const float* lat = (ph == 1) ? X : OUT; const float* cx = (ph == 1) ? CTX : HC;
            norm_rows(lat, cx, P.in[first ? I_N1G : I_N2G] + l * DM, MOD + (size_t)l * 9 * 6144, first ? 0 : 3072, first ? 1024 : 4096, ABUF, ph == 12 ? NLAT : MROWS, gw, ngw, lane);
        } else if ((ph == 2 || ph == 9) && PH_ON(2)) {
            const bool ev = ph == 2;
            pg8::Gemm g{ABUF, ev ? WE_IN : WO_QKV, MROWS, ev ? EVEN_IN : ODD_IN, DM}; pg8::StaticOrder S; S.init(g.M, g.N, G, bid);
            pg8::EpiQKV E{BIG, g.N, ev ? 1024 : 0, ev ? 1024 : 0, ev ? 2048 : 1280, ev ? 1536 : 1024, ROPE};
            pg8::gemm_phase<pg8::EpiQKV, pg8::StaticOrder, true, true>(lds, g, S, E, tid);
        } else if (ph == 3 && PH_ON(3)) {
            float lam;
            { const float d1 = wave_sum(P.in[I_LQ1][lane] * P.in[I_LK1][lane]), d2 = wave_sum(P.in[I_LQ2][lane] * P.in[I_LK2][lane]); lam = __expf(d1) - __expf(d2) + 0.2f; }
            for (int it = bid; it < 1088 + 1088; it += G) {
                if (it < 1024) { const int b = it >> 7, h = (it >> 5) & 3, qb = it & 31;
                    diff_attn_unit(lds, BIG, MIX, P.in[I_SUBLN], lam, 0.8f, b * SEQ + qb * 128, h, b * SEQ, 64, NLAT + b * CTXL, 68, tid, wave, lane);
                } else if (it < 1088) { const int u = it - 1024, b = u >> 3, h = (u >> 1) & 3, qb = u & 1;
                    diff_attn_unit(lds, BIG, MIX, P.in[I_SUBLN], lam, 0.8f, NLAT + b * CTXL + qb * 128, h, 0, 0, NLAT + b * CTXL, 4, tid, wave, lane);
                } else { const int u = it - 1088; chunk_mlp_unit(lds, BIG, SGU, P.in[I_SGU_B], MIX, u >> 2, u & 3, tid, wave, lane); }
            }
        } else if ((ph == 4 || ph == 7 || ph == 11 || ph == 14) && PH_ON(4)) {
            const int l = ph >= 8 ? 1 : 0; const bool ffn = (ph == 7 || ph == 14);
            pg8::Gemm g{ffn ? BIG : MIX, ffn ? WF_OUT + (size_t)l * DM * FFH : (l ? WO_OUT : WE_OUT), l ? NLAT : MROWS, DM, ffn ? FFH : DM}; pg8::StaticOrder S; S.init(g.M, g.N, G, bid);
            pg8::EpiRes E{ph == 4 ? X : OUT, ph == 4 ? CTX : HC, OUT, HC, MOD + (size_t)l * 9 * 6144 + (ffn ? 5120 : 2048)};
            pg8::gemm_phase<pg8::EpiRes, pg8::StaticOrder, true, true>(lds, g, S, E, tid);
        } else if ((ph == 6 || ph == 13) && PH_ON(6)) {
            const int l = ph == 13 ? 1 : 0;
            pg8::Gemm g{ABUF, WF_IN + (size_t)l * 2 * FFH * DM, l ? NLAT : MROWS, 2 * FFH, DM}; pg8::StaticOrder S; S.init(g.M, g.N, G, bid);
            pg8::EpiSwiglu E{BIG};
            pg8::gemm_phase<pg8::EpiSwiglu, pg8::StaticOrder, true, true>(lds, g, S, E, tid);
        } else if (ph == 10 && PH_ON(10)) {
            for (int it = bid; it < 2048; it += G) win_attn_unit(lds, BIG, MIX, P.in[I_SINK], it >> 8, (it >> 6) & 3, (it & 63) * 64, tid, wave, lane);
        } else if (ph == 15 && PH_ON(15)) {
            const float* fg = P.in[I_FINAL_G];
            for (int row = gw; row < NLAT; row += ngw) {
                f32x4* xr = (f32x4*)(OUT + (size_t)row * DM) + lane;
                f32x4 v[4]; float ss = 0.f;
#pragma unroll
                for (int j = 0; j < 4; ++j) { v[j] = xr[64 * j]; ss += (v[j][0] * v[j][0] + v[j][1] * v[j][1]) + (v[j][2] * v[j][2] + v[j][3] * v[j][3]); }
                const float rstd = 1.0f / sqrtf(wave_sum(ss) * (1.0f / DM) + EPS);
#pragma unroll
                for (int j = 0; j < 4; ++j) { const f32x4 gg = *(const f32x4*)(fg + 4 * lane + 256 * j); xr[64 * j] = v[j] * rstd * gg; }
            }
        }
        if (ph + 1 < P.ph_hi) grid.sync();
    }
}

extern "C" void kernel_launch(void* const* d_in, const int* in_sizes, int n_in, void* d_out, int out_size, void* d_ws, size_t ws_size, hipStream_t stream) {
    static int grid = 0;
    if (grid == 0) {
        if (n_in != 23 || ws_size < WS_END) { fprintf(stderr, "kernel_launch: unexpected n_in %d / ws %zu (need %zu)\n", n_in, ws_size, (size_t)WS_END); grid = -1; return; }
        int dev = 0, cus = 0, per_cu = 0;
        (void)hipGetDevice(&dev);
        (void)hipDeviceGetAttribute(&cus, hipDeviceAttributeMultiprocessorCount, dev);
        if (hipFuncSetAttribute((const void*)mega_fwd, hipFuncAttributeMaxDynamicSharedMemorySize, LDS_BYTES) != hipSuccess) fprintf(stderr, "kernel_launch: hipFuncSetAttribute failed\n");
        if (hipOccupancyMaxActiveBlocksPerMultiprocessor(&per_cu, (const void*)mega_fwd, 512, LDS_BYTES) != hipSuccess || per_cu < 1) { fprintf(stderr, "kernel_launch: occupancy query gave %d\n", per_cu); per_cu = 1; }
        (void)hipGetLastError();
        grid = cus * (per_cu > 1 ? 1 : per_cu);
        if (grid <= 0) grid = 256;
    }
    if (grid < 0) return;
    Params p{};
    for (int i = 0; i < 23; ++i) p.in[i] = (const float*)d_in[i];
    p.out = (float*)d_out; p.ws = (unsigned char*)d_ws; p.ph_lo = 0; p.ph_hi = NPHASE;
    void* args[] = {&p};
    hipError_t e = hipLaunchCooperativeKernel((const void*)mega_fwd, dim3(grid), dim3(512), args, LDS_BYTES, stream);
    if (e != hipSuccess) fprintf(stderr, "kernel_launch: cooperative launch failed: %s (grid %d)\n", hipGetErrorString(e), grid);
}
```

```cpp
#include <hip/hip_runtime.h>
#include <hip/hip_cooperative_groups.h>
#include <cstdio>
#include <cstdint>
namespace cg = cooperative_groups;

#define LAS __attribute__((address_space(3)))
typedef unsigned short bf16_t;
typedef short bf16x8 __attribute__((ext_vector_type(8)));
typedef float f32x4 __attribute__((ext_vector_type(4)));
typedef float f32x2 __attribute__((ext_vector_type(2)));
typedef float f32x16 __attribute__((ext_vector_type(16)));
typedef unsigned u32x4 __attribute__((ext_vector_type(4)));
typedef unsigned u32x2 __attribute__((ext_vector_type(2)));
typedef __bf16 bf16v2 __attribute__((ext_vector_type(2)));

constexpr int DM = 1024, NB = 8, SEQ = 4096, NLAT = NB * SEQ, CTXL = 256, NCTX = NB * CTXL, MROWS = NLAT + NCTX;
constexpr int FFH = 2816, EVEN_IN = 2560, ODD_IN = 1536;
constexpr float EPS = 1e-6f;
constexpr float LOG2E = 1.4426950408889634f;
constexpr float QSCALE = 0.125f * LOG2E;
constexpr float NEGB = -1e30f;

constexpr size_t WS_WE_IN = 0;
constexpr size_t WS_WE_OUT = WS_WE_IN + (size_t)EVEN_IN * DM * 2;
constexpr size_t WS_WF_IN = WS_WE_OUT + (size_t)DM * DM * 2;
constexpr size_t WS_WF_OUT = WS_WF_IN + 2 * (size_t)(2 * FFH) * DM * 2;
constexpr size_t WS_WO_QKV = WS_WF_OUT + 2 * (size_t)DM * FFH * 2;
constexpr size_t WS_WO_OUT = WS_WO_QKV + (size_t)ODD_IN * DM * 2;
constexpr size_t WS_SGU = WS_WO_OUT + (size_t)DM * DM * 2;
constexpr size_t WS_MOD = WS_SGU + 4 * 128 * 128 * 2;
constexpr size_t WS_ROPE = WS_MOD + 2 * 9 * 6144 * 4;
constexpr size_t WS_HC = WS_ROPE + 8192;
constexpr size_t WS_A = WS_HC + (size_t)NCTX * DM * 4;
constexpr size_t WS_MIX = WS_A + (size_t)MROWS * DM * 2;
constexpr size_t WS_BIG = WS_MIX + (size_t)MROWS * DM * 2;
constexpr size_t WS_HB = WS_BIG + (size_t)MROWS * FFH * 2;
constexpr size_t WS_PART = WS_HB + (size_t)MROWS * DM * 2;
constexpr size_t WS_BAR = WS_PART + 4 * (size_t)NCTX * DM * 4;
constexpr size_t WS_END = WS_BAR + 16384;

constexpr int LDS_BYTES = 131072 + 16;

__device__ __forceinline__ unsigned pk2(float lo, float hi) { f32x2 v = {lo, hi}; bf16v2 b = __builtin_convertvector(v, bf16v2); return __builtin_bit_cast(unsigned, b); }
__device__ __forceinline__ float bf_lo(unsigned w) { return __uint_as_float(w << 16); }
__device__ __forceinline__ float bf_hi(unsigned w) { return __uint_as_float(w & 0xffff0000u); }
__device__ __forceinline__ float shx(float v, int mask, int lane) { return __builtin_bit_cast(float, __builtin_amdgcn_ds_bpermute((lane ^ mask) << 2, __builtin_bit_cast(int, v))); }
__device__ __forceinline__ float wave_sum(float v, int lane) {
#pragma unroll
    for (int o = 1; o < 64; o <<= 1) v += shx(v, o, lane);
    return v;
}
__device__ __forceinline__ float fexp2(float x) { return __builtin_amdgcn_exp2f(x); }

namespace pg8 {
#define PG8_LAS __attribute__((address_space(3)))
constexpr int BM = 256, BK = 64, HALF = 128, HTB = HALF * BK * 2, STAGE_BYTES = 8 * HTB, NXCD = 8, WGM = 8;
__host__ __device__ __forceinline__ int lds_byte(int r, int c) { const int st = (r >> 4) * 2 + (c >> 5), rr = r & 15, cc = c & 31, ob = rr * 64 + cc * 2; return st * 1024 + (ob ^ (((ob >> 9) & 1) << 5)); }
__host__ __device__ __forceinline__ void stage_rc(int b, int& R, int& C) { const int st = b / 1024, sb = b % 1024, swz = sb ^ (((sb >> 9) & 1) << 5); R = (st >> 1) * 16 + swz / 64; C = (st & 1) * 32 + (swz % 64) / 2; }
__host__ __device__ __forceinline__ int perm32(int rho) { const int n = rho >> 4, i = rho & 15; return 8 * (i >> 2) + 4 * n + (i & 3); }

struct Unit { int pm, pn, pk; };
struct Gemm { const bf16_t* A; const bf16_t* Bt; int M, N, K, ld; };

struct StaticOrder {
    int nM, nN, nwg, G, c;
    __host__ __device__ void init(int M, int N, int G_, int c_) { nM = M / BM; nN = N / BM; nwg = nM * nN; G = G_; c = c_; }
    __host__ __device__ bool next(int i, Unit& u) const {
        const long L = (long)i * G + c; if (L >= nwg) return false;
        int wgid = (int)L; { const int q = nwg / NXCD, r = nwg % NXCD, xcd = wgid % NXCD, off = wgid / NXCD; wgid = (xcd < r ? xcd * (q + 1) : r * (q + 1) + (xcd - r) * q) + off; }
        const int nig = WGM * nN, gid = wgid / nig, fm = gid * WGM, gsz = (nM - fm) < WGM ? (nM - fm) : WGM;
        u.pm = fm + ((wgid % nig) % gsz); u.pn = (wgid % nig) / gsz; u.pk = 0; return true;
    }
    __device__ __forceinline__ void a_ready(const Unit&) const {}
    __device__ __forceinline__ void done(const Unit&) const {}
};

struct SplitOrder {
    int pm0, nM, nN, nK, G, c;
    __device__ bool next(int i, Unit& u) const {
        const long L = (long)i * G + c; if (L >= (long)nM * nN * nK) return false;
        const int l = (int)L; u.pk = l % nK; const int r = l / nK; u.pn = r % nN; u.pm = pm0 + r / nN; return true;
    }
    __device__ __forceinline__ void a_ready(const Unit&) const {}
    __device__ __forceinline__ void done(const Unit&) const {}
};

__device__ __forceinline__ f32x2 gelu_pk(f32x2 v) {
    const f32x2 av = __builtin_elementwise_abs(v), d = av * 0.2316418882f + 1.0f;
    f32x2 t; t.x = __builtin_amdgcn_rcpf(d.x); t.y = __builtin_amdgcn_rcpf(d.y);
    f32x2 q = t * 0.5307027145f + (-0.7265760135f); q = q * t + 0.7107068705f; q = q * t + (-0.142248368f); q = q * t + 0.127414796f; q = q * t;
    const f32x2 s = (v * v) * (-0.72134752044f);
    f32x2 e; e.x = __builtin_amdgcn_exp2f(s.x); e.y = __builtin_amdgcn_exp2f(s.y);
    const f32x2 m = v * (q * e), r = v - m;
    f32x2 o; o.x = v.x < 0.f ? m.x : r.x; o.y = v.y < 0.f ? m.y : r.y; return o;
}
__device__ __forceinline__ f32x4 gelu4(f32x4 v) { f32x2 a = gelu_pk((f32x2){v[0], v[1]}), b = gelu_pk((f32x2){v[2], v[3]}); return (f32x4){a.x, a.y, b.x, b.y}; }


struct EpiQKV {
    static constexpr bool PERM = false, AFTER_DRAIN = false;
    bf16_t* O; int ldc, gelu_end, rope_lo, rope_hi, q_hi; const float* rope;
    __device__ __forceinline__ void operator()(const f32x4 (&acc)[2][2][4][2], const Unit& u, int wr, int wc, int fr, int fq) const {
#pragma unroll
        for (int ai = 0; ai < 2; ++ai)
#pragma unroll
            for (int m = 0; m < 4; ++m) {
                const int row = u.pm * BM + ai * HALF + wr * 64 + m * 16 + fr;
                const bool lat = row < NLAT; const int t = row & (SEQ - 1); const int pos = (wc & 1) ? (t & 63) : (t >> 6);
                bf16_t* rowp = O + (size_t)row * ldc + u.pn * BM + wc * 32 + 4 * fq;
#pragma unroll
                for (int bj = 0; bj < 2; ++bj) {
                    const int colb = u.pn * BM + bj * HALF;
                    f32x4 v0 = acc[ai][bj][m][0], v1 = acc[ai][bj][m][1];
                    if (colb < gelu_end) { v0 = gelu4(v0); v1 = gelu4(v1); }
                    else if (colb >= rope_lo && colb < rope_hi) {
                        if (lat) {
                            const f32x4 c4 = *(const f32x4*)(rope + pos * 16 + 4 * fq), s4 = *(const f32x4*)(rope + 1024 + pos * 16 + 4 * fq);
                            const f32x4 o0 = v0 * c4 - v1 * s4, o1 = v1 * c4 + v0 * s4; v0 = o0; v1 = o1;
                        }
                        if (colb < q_hi) { v0 = v0 * QSCALE; v1 = v1 * QSCALE; }
                    }
                    u32x2 w0, w1; w0.x = pk2(v0[0], v0[1]); w0.y = pk2(v0[2], v0[3]); w1.x = pk2(v1[0], v1[1]); w1.y = pk2(v1[2], v1[3]);
                    *(u32x2*)(rowp + bj * HALF) = w0; *(u32x2*)(rowp + bj * HALF + 16) = w1;
                }
            }
    }
};
template <bool BASE_F32>
struct EpiRes {
    static constexpr bool PERM = true, AFTER_DRAIN = false;
    const float* base_lat; const float* base_ctx; bf16_t* hb; const float* gate;
    __device__ __forceinline__ void operator()(const f32x4 (&acc)[2][2][4][2], const Unit& u, int wr, int wc, int fr, int fq) const {
        const int row0 = u.pm * BM; const bool lat = row0 < NLAT; const int ridx = lat ? (row0 >> 12) : 8;
        const int cb = u.pn * BM + wc * 32 + 8 * fq;
        bf16_t* hrow = hb + (size_t)(row0 + wr * 64 + fr) * DM + cb;
        const float* brow = (lat ? base_lat + (size_t)row0 * DM : base_ctx + (size_t)(row0 - NLAT) * DM) + (size_t)(wr * 64 + fr) * DM + cb;
#pragma unroll
        for (int bj = 0; bj < 2; ++bj) {
            const int co = bj * HALF;
            const f32x4 g0 = *(const f32x4*)(gate + ridx * 6144 + cb + co), g1 = *(const f32x4*)(gate + ridx * 6144 + cb + co + 4);
#pragma unroll
            for (int ai = 0; ai < 2; ++ai) {
                f32x4 b0[4], b1[4];
                if (BASE_F32) {
#pragma unroll
                    for (int m = 0; m < 4; ++m) { const float* p = brow + (size_t)(ai * HALF + m * 16) * DM + co; b0[m] = *(const f32x4*)p; b1[m] = *(const f32x4*)(p + 4); }
                } else {
                    u32x4 raw[4];
#pragma unroll
                    for (int m = 0; m < 4; ++m) raw[m] = *(const u32x4*)(hrow + (size_t)(ai * HALF + m * 16) * DM + co);
#pragma unroll
                    for (int m = 0; m < 4; ++m) { b0[m] = (f32x4){bf_lo(raw[m].x), bf_hi(raw[m].x), bf_lo(raw[m].y), bf_hi(raw[m].y)}; b1[m] = (f32x4){bf_lo(raw[m].z), bf_hi(raw[m].z), bf_lo(raw[m].w), bf_hi(raw[m].w)}; }
                }
#pragma unroll
                for (int m = 0; m < 4; ++m) {
                    const f32x4 h0 = b0[m] + g0 * acc[ai][bj][m][0], h1 = b1[m] + g1 * acc[ai][bj][m][1];
                    u32x4 w; w.x = pk2(h0[0], h0[1]); w.y = pk2(h0[2], h0[3]); w.z = pk2(h1[0], h1[1]); w.w = pk2(h1[2], h1[3]);
                    *(u32x4*)(hrow + (size_t)(ai * HALF + m * 16) * DM + co) = w;
                }
            }
        }
    }
};
struct EpiPart {
    static constexpr bool PERM = false, AFTER_DRAIN = false;
    float* part;
    __device__ __forceinline__ void operator()(const f32x4 (&acc)[2][2][4][2], const Unit& u, int wr, int wc, int fr, int fq) const {
        float* base = part + ((size_t)u.pk * NCTX + (size_t)(u.pm * BM - NLAT + wr * 64 + fr)) * DM + u.pn * BM + wc * 32 + 4 * fq;
#pragma unroll
        for (int ai = 0; ai < 2; ++ai)
#pragma unroll
            for (int m = 0; m < 4; ++m)
#pragma unroll
                for (int bj = 0; bj < 2; ++bj)
#pragma unroll
                    for (int n = 0; n < 2; ++n) *(f32x4*)(base + (size_t)(ai * HALF + m * 16) * DM + bj * HALF + n * 16) = acc[ai][bj][m][n];
    }
};
struct EpiSwiglu {
    static constexpr bool PERM = true, AFTER_DRAIN = false;
    bf16_t* H;
    __device__ __forceinline__ void operator()(const f32x4 (&acc)[2][2][4][2], const Unit& u, int wr, int wc, int fr, int fq) const {
#pragma unroll
        for (int ai = 0; ai < 2; ++ai)
#pragma unroll
            for (int m = 0; m < 4; ++m) {
                const int row = u.pm * BM + ai * HALF + wr * 64 + m * 16 + fr;
                bf16_t* p = H + (size_t)row * FFH + u.pn * HALF + wc * 32 + 8 * fq;
                float r[8];
#pragma unroll
                for (int n = 0; n < 2; ++n)
#pragma unroll
                    for (int j = 0; j < 4; ++j) { const float g = acc[ai][0][m][n][j], uu = acc[ai][1][m][n][j];
                        r[4 * n + j] = g * __builtin_amdgcn_rcpf(1.0f + __builtin_amdgcn_exp2f(-g * LOG2E)) * uu; }
                u32x4 w; w.x = pk2(r[0], r[1]); w.y = pk2(r[2], r[3]); w.z = pk2(r[4], r[5]); w.w = pk2(r[6], r[7]);
                *(u32x4*)p = w;
            }
    }
};

template <class Epi, class Sched, bool ALIGN_EPI = false, bool SP2 = false>
__device__ __forceinline__ void gemm_phase(PG8_LAS unsigned char* lds, const Gemm g, const Sched& S, const Epi& E, const int tid) {
    const int wid = __builtin_amdgcn_readfirstlane(tid >> 6), lane = tid & 63, wr = wid >> 2, wc = wid & 3, fr = lane & 15, fq = lane >> 4;
    const int K = g.K, ld = g.ld, nt = K / BK;
    unsigned voffA[2], voffB[2];
#pragma unroll
    for (int i = 0; i < 2; ++i) { int R, C; stage_rc(tid * 16 + i * 8192, R, C); const int Rb = Epi::PERM ? ((R & ~31) + perm32(R & 31)) : R;
        voffA[i] = (unsigned)(R * ld + C) * 2u; voffB[i] = (unsigned)(Rb * ld + C) * 2u; }
    const size_t kstep = (size_t)(BK * 2);
    const size_t hstep = (size_t)HALF * ld * 2;
    const size_t kchunk = (size_t)K * 2;
    const size_t tstep = 2 * hstep;
    const unsigned ldsw = (unsigned)wid * 1024u;
    const int aoff = lds_byte(wr * 64 + fr, fq * 8), boff = lds_byte(wc * 32 + fr, fq * 8);
#define PG8_SA(b, h) (((b) * 2 + (h)) * HTB)
#define PG8_SB(b, h) ((4 + (b) * 2 + (h)) * HTB)
#define PG8_STAGE(bufoff, gbase, voff) do { _Pragma("unroll") for (int _i = 0; _i < 2; ++_i) \
        __builtin_amdgcn_global_load_lds((const unsigned*)((const char*)(gbase) + (voff)[_i]), (PG8_LAS unsigned*)(lds + (bufoff) + ldsw + _i * 8192), 16, 0, 0); } while (0)
#define PG8_LDA(dst, b, h) do { _Pragma("unroll") for (int m = 0; m < 4; ++m) _Pragma("unroll") for (int k = 0; k < 2; ++k) dst[m][k] = *(const PG8_LAS bf16x8*)(lds + PG8_SA(b, h) + aoff + m * 2048 + k * 1024); } while (0)
#define PG8_LDB(dst, b, h) do { _Pragma("unroll") for (int n = 0; n < 2; ++n) _Pragma("unroll") for (int k = 0; k < 2; ++k) dst[n][k] = *(const PG8_LAS bf16x8*)(lds + PG8_SB(b, h) + boff + n * 2048 + k * 1024); } while (0)
#define PG8_MMA(ai, bj, At, Bt) do { __builtin_amdgcn_s_setprio(1); _Pragma("unroll") for (int m = 0; m < 4; ++m) _Pragma("unroll") for (int n = 0; n < 2; ++n) _Pragma("unroll") for (int k = 0; k < 2; ++k) \
        acc[ai][bj][m][n] = __builtin_amdgcn_mfma_f32_16x16x32_bf16(Bt[n][k], At[m][k], acc[ai][bj][m][n], 0, 0, 0); __builtin_amdgcn_s_setprio(0); } while (0)
#define PG8_WAIT_V(n) asm volatile("s_waitcnt vmcnt(" #n ")" ::: "memory")
#define PG8_WAIT_L(n) asm volatile("s_waitcnt lgkmcnt(" #n ")" ::: "memory")
#define PG8_BAR __builtin_amdgcn_s_barrier()
#define PG8_SCHED __builtin_amdgcn_sched_barrier(0)
    Unit cur, nxt; int ui = 0;
    if (!S.next(0, cur)) return;
    f32x4 acc[2][2][4][2];
#pragma unroll
    for (int a = 0; a < 2; ++a)
#pragma unroll
        for (int b = 0; b < 2; ++b)
#pragma unroll
            for (int m = 0; m < 4; ++m)
#pragma unroll
                for (int n = 0; n < 2; ++n) acc[a][b][m][n] = (f32x4){0.f, 0.f, 0.f, 0.f};
    bf16x8 At[4][2], B0[2][2], B1[2][2];
    const char* cA = (const char*)g.A + (size_t)cur.pm * tstep + (size_t)cur.pk * kchunk; const char* cB = (const char*)g.Bt + (size_t)cur.pn * tstep + (size_t)cur.pk * kchunk;
    S.a_ready(cur);
    if constexpr (SP2) {
        PG8_STAGE(PG8_SB(0, 0), cB, voffB); PG8_STAGE(PG8_SB(0, 1), cB + hstep, voffB); PG8_STAGE(PG8_SA(0, 0), cA, voffA); PG8_STAGE(PG8_SA(0, 1), cA + hstep, voffA);
        if (wr == 1) PG8_BAR;
        PG8_WAIT_V(2); PG8_BAR;
        PG8_STAGE(PG8_SB(1, 0), cB + kstep, voffB); PG8_STAGE(PG8_SA(1, 0), cA + kstep, voffA); PG8_STAGE(PG8_SB(1, 1), cB + hstep + kstep, voffB);
        PG8_WAIT_V(6); PG8_BAR;
    } else {
        PG8_STAGE(PG8_SB(0, 0), cB, voffB); PG8_STAGE(PG8_SA(0, 0), cA, voffA); PG8_STAGE(PG8_SB(0, 1), cB + hstep, voffB); PG8_STAGE(PG8_SA(0, 1), cA + hstep, voffA);
        if (wr == 1) PG8_BAR;
        PG8_WAIT_V(4); PG8_BAR;
        PG8_STAGE(PG8_SB(1, 0), cB + kstep, voffB); PG8_STAGE(PG8_SA(1, 0), cA + kstep, voffA); PG8_STAGE(PG8_SB(1, 1), cB + hstep + kstep, voffB);
        PG8_WAIT_V(6); PG8_BAR;
    }
    for (;;) {
        const bool has_next = S.next(ui + 1, nxt);
        const char* nA = has_next ? (const char*)g.A + (size_t)nxt.pm * tstep + (size_t)nxt.pk * kchunk : cA; const char* nB = has_next ? (const char*)g.Bt + (size_t)nxt.pn * tstep + (size_t)nxt.pk * kchunk : cB;
        for (int t = 0; t < nt; t += 2) {
            const bool last = (t == nt - 2);
            const char* a1 = cA + (size_t)(t + 1) * kstep;
            const char* a2 = last ? nA : cA + (size_t)(t + 2) * kstep; const char* b2 = last ? nB : cB + (size_t)(t + 2) * kstep;
            const char* a3 = a2 + kstep; const char* b3 = b2 + kstep;
            if (last && has_next) S.a_ready(nxt);
            if constexpr (SP2) {
            PG8_LDB(B0, 0, 0); PG8_LDB(B1, 0, 1); PG8_SCHED; PG8_LDA(At, 0, 0); PG8_STAGE(PG8_SA(1, 1), a1 + hstep, voffA);
            PG8_WAIT_V(8); PG8_WAIT_L(0); PG8_BAR; PG8_MMA(0, 0, At, B0); PG8_MMA(0, 1, At, B1); PG8_BAR; PG8_SCHED;
            PG8_LDA(At, 0, 1); PG8_STAGE(PG8_SB(0, 0), b2, voffB); PG8_STAGE(PG8_SB(0, 1), b2 + hstep, voffB); PG8_STAGE(PG8_SA(0, 0), a2, voffA);
            PG8_WAIT_V(8); PG8_WAIT_L(0); PG8_BAR; PG8_MMA(1, 0, At, B0); PG8_MMA(1, 1, At, B1); PG8_BAR; PG8_SCHED;
            PG8_LDB(B0, 1, 0); PG8_LDB(B1, 1, 1); PG8_SCHED; PG8_LDA(At, 1, 0); PG8_STAGE(PG8_SA(0, 1), a2 + hstep, voffA);
            PG8_WAIT_V(8); PG8_WAIT_L(0); PG8_BAR; PG8_MMA(0, 0, At, B0); PG8_MMA(0, 1, At, B1); PG8_BAR; PG8_SCHED;
            PG8_LDA(At, 1, 1); PG8_STAGE(PG8_SB(1, 0), b3, voffB); PG8_STAGE(PG8_SB(1, 1), b3 + hstep, voffB); PG8_STAGE(PG8_SA(1, 0), a3, voffA);
            PG8_WAIT_V(8); PG8_WAIT_L(0); PG8_BAR; PG8_MMA(1, 0, At, B0); PG8_MMA(1, 1, At, B1); PG8_BAR; PG8_SCHED;
            } else {
            PG8_LDB(B0, 0, 0); PG8_SCHED; PG8_LDA(At, 0, 0); PG8_STAGE(PG8_SA(1, 1), a1 + hstep, voffA);
            PG8_WAIT_L(8); PG8_BAR; PG8_WAIT_L(0); PG8_MMA(0, 0, At, B0); PG8_BAR; PG8_SCHED;
            PG8_LDB(B1, 0, 1); PG8_STAGE(PG8_SB(0, 0), b2, voffB);
            PG8_BAR; PG8_WAIT_L(0); PG8_MMA(0, 1, At, B1); PG8_BAR;
            PG8_LDA(At, 0, 1); PG8_STAGE(PG8_SA(0, 0), a2, voffA);
            PG8_BAR; PG8_WAIT_L(0); PG8_MMA(1, 0, At, B0); PG8_BAR; PG8_SCHED;
            PG8_STAGE(PG8_SB(0, 1), b2 + hstep, voffB);
            PG8_WAIT_V(6); PG8_BAR; PG8_MMA(1, 1, At, B1); PG8_BAR;
            PG8_LDB(B0, 1, 0); PG8_SCHED; PG8_LDA(At, 1, 0); PG8_STAGE(PG8_SA(0, 1), a2 + hstep, voffA);
            PG8_WAIT_L(8); PG8_BAR; PG8_WAIT_L(0); PG8_MMA(0, 0, At, B0); PG8_BAR; PG8_SCHED;
            PG8_LDB(B1, 1, 1); PG8_STAGE(PG8_SB(1, 0), b3, voffB);
            PG8_BAR; PG8_WAIT_L(0); PG8_MMA(0, 1, At, B1); PG8_BAR;
            PG8_LDA(At, 1, 1); PG8_STAGE(PG8_SA(1, 0), a3, voffA);
            PG8_BAR; PG8_WAIT_L(0); PG8_MMA(1, 0, At, B0); PG8_BAR; PG8_SCHED;
            PG8_STAGE(PG8_SB(1, 1), b3 + hstep, voffB);
            PG8_WAIT_V(6); PG8_BAR; PG8_MMA(1, 1, At, B1); PG8_BAR;
            }
        }
        if constexpr (ALIGN_EPI) { if (wr == 0) PG8_BAR; }
        if constexpr (!Epi::AFTER_DRAIN) { E(acc, cur, wr, wc, fr, fq); S.done(cur); }
        if (!has_next) break;
#pragma unroll
        for (int a = 0; a < 2; ++a)
#pragma unroll
            for (int b = 0; b < 2; ++b)
#pragma unroll
                for (int m = 0; m < 4; ++m)
#pragma unroll
                    for (int n = 0; n < 2; ++n) acc[a][b][m][n] = (f32x4){0.f, 0.f, 0.f, 0.f};
        cur = nxt; cA = nA; cB = nB; ++ui;
        if constexpr (ALIGN_EPI) { if (wr == 1) PG8_BAR; }
    }
    PG8_WAIT_V(0);
    if constexpr (!ALIGN_EPI) { if (wr == 0) PG8_BAR; }
    PG8_BAR;
#undef PG8_SA
#undef PG8_SB
#undef PG8_STAGE
#undef PG8_LDA
#undef PG8_LDB
#undef PG8_MMA
#undef PG8_WAIT_V
#undef PG8_WAIT_L
#undef PG8_BAR
#undef PG8_SCHED
}
}

__device__ __forceinline__ void transpose_item(const float* __restrict__ W, int K, int N, bf16_t* WT, int drow0, int k0, int n0, LAS float* scr, int lane) {
#pragma unroll 8
    for (int i = 0; i < 32; ++i) { const int kk = 2 * i + (lane >> 5); scr[kk * 33 + (lane & 31)] = W[(size_t)(k0 + kk) * N + n0 + (lane & 31)]; }
    asm volatile("s_waitcnt lgkmcnt(0)" ::: "memory");
    const int c = lane & 7;
#pragma unroll
    for (int j = 0; j < 4; ++j) { const int n = (lane >> 3) + 8 * j; const LAS float* s = scr + (8 * c) * 33 + n;
        u32x4 o; o.x = pk2(s[0 * 33], s[1 * 33]); o.y = pk2(s[2 * 33], s[3 * 33]); o.z = pk2(s[4 * 33], s[5 * 33]); o.w = pk2(s[6 * 33], s[7 * 33]);
        *(u32x4*)(WT + (size_t)(drow0 + n) * K + k0 + 8 * c) = o; }
    asm volatile("s_waitcnt lgkmcnt(0)" ::: "memory");
}
template <bool FFN_IN>
__device__ __forceinline__ void transpose_mat(const float* W, int K, int N, bf16_t* WT, int item, LAS float* scr, int lane) {
    const int nblk = N / 32, kb = item / nblk, nb = item % nblk, n0 = nb * 32;
    int drow0 = n0;
    if (FFN_IN) { const int hf = n0 >= FFH ? 1 : 0; const int j = n0 - hf * FFH; drow0 = 256 * (j >> 7) + 128 * hf + (j & 127); }
    transpose_item(W, K, N, WT, drow0, kb * 64, n0, scr, lane);
}

#define MFMA32(a, b, c) __builtin_amdgcn_mfma_f32_32x32x16_bf16((a), (b), (c), 0, 0, 0)
typedef short s16x4 __attribute__((ext_vector_type(4)));
constexpr float LAZY_THR = 8.0f;

template <int EB, bool MASKED, int VSTR>
__device__ __forceinline__ void flash_tile(const LAS unsigned char* kb, const int kstr, const LAS unsigned char* vb, const bf16x8 (&qf)[4], f32x16 (&O)[EB], f32x16& negm,
                                           float& m, float& lsum, float& pmx, const int l32, const int half, const int qpos, const int kpos0) {
    if (__any(pmx > 4096.0f)) {
        const float delta = fmaxf(__builtin_amdgcn_logf(pmx) - 6.0f, 0.0f);
        const float alpha = fexp2(-delta);
        m += delta; lsum *= alpha;
#pragma unroll
        for (int i = 0; i < 16; ++i) negm[i] = -m;
#pragma unroll
        for (int eb = 0; eb < EB; ++eb) O[eb] = O[eb] * alpha;
    }
    f32x16 s0 = negm, s1 = negm;
    {
        bf16x8 ka[8];
        const LAS unsigned char* kp = kb + l32 * kstr + half * 16;
#pragma unroll
        for (int ks = 0; ks < 4; ++ks) { ka[ks] = *(const LAS bf16x8*)(kp + ks * 32); ka[4 + ks] = *(const LAS bf16x8*)(kp + 32 * kstr + ks * 32); }
        __builtin_amdgcn_sched_barrier(0);
#pragma unroll
        for (int ks = 0; ks < 4; ++ks) { s0 = MFMA32(ka[ks], qf[ks], s0); s1 = MFMA32(ka[4 + ks], qf[ks], s1); }
    }
    float psa = 0.f, psb = 0.f;
#pragma unroll
    for (int kbk = 0; kbk < 2; ++kbk) {
        f32x16 sv = kbk == 0 ? s0 : s1;
        if (MASKED) {
#pragma unroll
            for (int i = 0; i < 16; ++i) { const int d = qpos - (kpos0 + 32 * kbk + (i & 3) + 8 * (i >> 2) + 4 * half); if (d > 128 || d < -128) sv[i] = NEGB; }
        }
#pragma unroll
        for (int i = 0; i < 16; i += 2) { sv[i] = fexp2(sv[i]); sv[i + 1] = fexp2(sv[i + 1]); psa += sv[i]; psb += sv[i + 1]; }
#pragma unroll
        for (int st = 0; st < 2; ++st) {
            u32x4 p; p.x = pk2(sv[8 * st + 0], sv[8 * st + 1]); p.y = pk2(sv[8 * st + 2], sv[8 * st + 3]); p.z = pk2(sv[8 * st + 4], sv[8 * st + 5]); p.w = pk2(sv[8 * st + 6], sv[8 * st + 7]);
            const bf16x8 pf = __builtin_bit_cast(bf16x8, p);
#pragma unroll
            for (int eb = 0; eb < EB; ++eb) {
                const LAS unsigned char* a = vb + (32 * kbk + 16 * st) * VSTR + 64 * eb;
                const s16x4 lo = __builtin_amdgcn_ds_read_tr16_b64_v4i16((LAS s16x4*)a);
                const s16x4 hi = __builtin_amdgcn_ds_read_tr16_b64_v4i16((LAS s16x4*)(a + 8 * VSTR));
                const bf16x8 vf = __builtin_shufflevector(lo, hi, 0, 1, 2, 3, 4, 5, 6, 7);
                O[eb] = MFMA32(vf, pf, O[eb]);
            }
        }
    }
    const float ps = psa + psb;
    lsum += ps;
    pmx = ps + shx(ps, 32, l32 | (half << 5));
}

constexpr int DA_KSTR = 272, DA_KB = 64 * DA_KSTR  , DA_VSTR = 320, DA_VT = 64 * DA_VSTR  ;
constexpr int DS_TILE = 16384, DS_STAGE = 2 * DS_TILE;
__device__ __forceinline__ void diff_attn_unit(LAS unsigned char* lds, const bf16_t* __restrict__ P1, bf16_t* __restrict__ MIX, const float* __restrict__ subln_g,
                                               const float lam, const float one_m_li, const int qrow0, const int h, const int krow_lat0, const int nlat, const int krow_ctx0, const int nt,
                                               const int tid, const int wave, const int lane) {
    const int l32 = lane & 31, half = lane >> 5;
    const int sj = wave & 1, qblk = wave >> 1;
    const int qrow = qrow0 + 32 * qblk + l32;
    bf16x8 qf[4];
    { const bf16_t* qp = P1 + (size_t)qrow * EVEN_IN + 1024 + h * 128 + sj * 64 + 8 * half;
#pragma unroll
      for (int ks = 0; ks < 4; ++ks) qf[ks] = *(const bf16x8*)(qp + 16 * ks); }
    f32x16 O[4], negm;
#pragma unroll
    for (int i = 0; i < 16; ++i) negm[i] = 0.f;
#pragma unroll
    for (int eb = 0; eb < 4; ++eb)
#pragma unroll
        for (int i = 0; i < 16; ++i) O[eb][i] = 0.f;
    float m = 0.f, l = 0.f, pmx = 0.f;
    int kof[4], vof[4];
#pragma unroll
    for (int ks = 0; ks < 4; ++ks) kof[ks] = l32 * 256 + (((sj * 8 + ks * 2 + half) ^ (l32 & 15)) << 4);
    { const int g4 = lane >> 4, q4 = (lane & 15) >> 2, p4 = lane & 3;
#pragma unroll
      for (int eb = 0; eb < 4; ++eb) vof[eb] = (4 * (g4 >> 1) + q4) * 256 + 64 * (eb ^ q4) + 32 * (g4 & 1) + 8 * p4; }
    const int srow = tid >> 4;
    const bf16_t* ksrc = P1 + (size_t)srow * EVEN_IN + 1536 + h * 128 + (((tid & 15) ^ (srow & 15)) << 3);
    const bf16_t* vsrc = P1 + (size_t)srow * EVEN_IN + 2048 + h * 128 + (((tid & 15) ^ (4 * (srow & 3))) << 3);
#define DA_ROW(t) (((t) < nlat) ? krow_lat0 + 64 * (t) : krow_ctx0 + 64 * ((t) - nlat))
#define DA_DMA(t, stg) do { const size_t ro_ = (size_t)DA_ROW(t) * EVEN_IN; LAS unsigned char* db_ = lds + (stg) * DS_STAGE + wave * 1024; \
        _Pragma("unroll") for (int i_ = 0; i_ < 2; ++i_) { \
            __builtin_amdgcn_global_load_lds((const unsigned*)(ksrc + ro_ + (size_t)(32 * i_) * EVEN_IN), (LAS unsigned*)(db_ + i_ * 8192), 16, 0, 0); \
            __builtin_amdgcn_global_load_lds((const unsigned*)(vsrc + ro_ + (size_t)(32 * i_) * EVEN_IN), (LAS unsigned*)(db_ + DS_TILE + i_ * 8192), 16, 0, 0); } } while (0)
    f32x16 sA0, sA1, sB0, sB1;
#pragma unroll
    for (int i = 0; i < 16; ++i) { sA0[i] = 0.f; sA1[i] = 0.f; sB0[i] = 0.f; sB1[i] = 0.f; }
#define DA_QK(S0, S1, kb_) do { S0 = negm; S1 = negm; \
        _Pragma("unroll") for (int ks = 0; ks < 4; ++ks) { const bf16x8 a0_ = *(const LAS bf16x8*)((kb_) + kof[ks]); const bf16x8 a1_ = *(const LAS bf16x8*)((kb_) + kof[ks] + 8192); \
            S0 = MFMA32(a0_, qf[ks], S0); S1 = MFMA32(a1_, qf[ks], S1); } } while (0)
#define DA_SMPV(S0, S1, vb_) do { float psa_ = 0.f, psb_ = 0.f; \
        _Pragma("unroll") for (int kbk = 0; kbk < 2; ++kbk) { f32x16 sv_ = kbk == 0 ? S0 : S1; \
            _Pragma("unroll") for (int i = 0; i < 16; i += 2) { sv_[i] = fexp2(sv_[i]); sv_[i + 1] = fexp2(sv_[i + 1]); psa_ += sv_[i]; psb_ += sv_[i + 1]; } \
            _Pragma("unroll") for (int st = 0; st < 2; ++st) { u32x4 p_; p_.x = pk2(sv_[8 * st + 0], sv_[8 * st + 1]); p_.y = pk2(sv_[8 * st + 2], sv_[8 * st + 3]); p_.z = pk2(sv_[8 * st + 4], sv_[8 * st + 5]); p_.w = pk2(sv_[8 * st + 6], sv_[8 * st + 7]); \
                const bf16x8 pf_ = __builtin_bit_cast(bf16x8, p_); \
                _Pragma("unroll") for (int eb = 0; eb < 4; ++eb) { const LAS unsigned char* a_ = (vb_) + vof[eb] + (32 * kbk + 16 * st) * 256; \
                    const s16x4 lo_ = __builtin_amdgcn_ds_read_tr16_b64_v4i16((LAS s16x4*)a_), hi_ = __builtin_amdgcn_ds_read_tr16_b64_v4i16((LAS s16x4*)(a_ + 8 * 256)); \
                    O[eb] = MFMA32(__builtin_shufflevector(lo_, hi_, 0, 1, 2, 3, 4, 5, 6, 7), pf_, O[eb]); } } } \
        const float ps_ = psa_ + psb_; l += ps_; pmx = ps_ + shx(ps_, 32, lane); } while (0)
#define DA_ITER(t, C0, C1, N0, N1) do { \
        if (__any(pmx > 4096.0f)) { const float delta_ = fmaxf(__builtin_amdgcn_logf(pmx) - 6.0f, 0.0f); const float alpha_ = fexp2(-delta_); m += delta_; l *= alpha_; \
            _Pragma("unroll") for (int i = 0; i < 16; ++i) { negm[i] = -m; C0[i] -= delta_; C1[i] -= delta_; } \
            _Pragma("unroll") for (int eb = 0; eb < 4; ++eb) O[eb] = O[eb] * alpha_; } \
        if ((t) + 3 < nt) DA_DMA((t) + 3, ((t) + 3) & 3); \
        if ((t) + 1 < nt) DA_QK(N0, N1, lds + (((t) + 1) & 3) * DS_STAGE); \
        DA_SMPV(C0, C1, lds + ((t) & 3) * DS_STAGE + DS_TILE); \
        if ((t) + 3 < nt) asm volatile("s_waitcnt vmcnt(4) lgkmcnt(0)" ::: "memory"); else asm volatile("s_waitcnt vmcnt(0) lgkmcnt(0)" ::: "memory"); \
        __builtin_amdgcn_s_barrier(); } while (0)
    DA_DMA(0, 0); DA_DMA(1, 1); DA_DMA(2, 2);
    asm volatile("s_waitcnt vmcnt(4)" ::: "memory");
    __builtin_amdgcn_s_barrier();
    DA_QK(sA0, sA1, lds);
    for (int t = 0; t < nt; t += 2) {
        DA_ITER(t, sA0, sA1, sB0, sB1);
        DA_ITER(t + 1, sB0, sB1, sA0, sA1);
    }
#undef DA_QK
#undef DA_SMPV
#undef DA_ITER
#undef DA_ROW
#undef DA_DMA
    l += shx(l, 32, lane);
    LAS float* xch = (LAS float*)lds + qblk * 4096 + lane;
    if (sj == 1) {
        const float i1 = lam / l;
#pragma unroll
        for (int eb = 0; eb < 4; ++eb)
#pragma unroll
            for (int i = 0; i < 16; ++i) xch[(eb * 16 + i) * 64] = O[eb][i] * i1;
    }
    __syncthreads();
    if (sj == 0) {
        const float i0 = 1.0f / l;
        float ss = 0.f;
#pragma unroll
        for (int eb = 0; eb < 4; ++eb)
#pragma unroll
            for (int i = 0; i < 16; ++i) { const float o = O[eb][i] * i0 - xch[(eb * 16 + i) * 64]; O[eb][i] = o; ss += o * o; }
        ss += shx(ss, 32, lane);
        const float r = one_m_li / sqrtf(ss * (1.0f / 128.0f) + EPS);
        bf16_t* op = MIX + (size_t)qrow * DM + 512 + h * 128 + 4 * half;
#pragma unroll
        for (int eb = 0; eb < 4; ++eb)
#pragma unroll
            for (int gi = 0; gi < 4; ++gi) {
                const int e0 = 32 * eb + 8 * gi;
                const f32x4 g4v = *(const f32x4*)(subln_g + e0 + 4 * half);
                u32x2 w; w.x = pk2(O[eb][4 * gi] * r * g4v[0], O[eb][4 * gi + 1] * r * g4v[1]); w.y = pk2(O[eb][4 * gi + 2] * r * g4v[2], O[eb][4 * gi + 3] * r * g4v[3]);
                *(u32x2*)(op + e0) = w;
            }
    }
    __syncthreads();
}

constexpr int WA_KB = 64 * 144  , WA_VSTR = 192, WA_VB = 64 * WA_VSTR  ;
__device__ __forceinline__ void win_attn_unit(LAS unsigned char* lds, const bf16_t* __restrict__ QKV, bf16_t* __restrict__ MIX, const float* __restrict__ sink,
                                              const int b, const int kvh, const int start, const int tid, const int wave, const int lane) {
    const int l32 = lane & 31, half = lane >> 5;
    LAS unsigned char* KB[2] = {lds, lds + WA_KB};
    LAS unsigned char* VT[2] = {lds + 2 * WA_KB, lds + 2 * WA_KB + WA_VB};
    const int head = kvh * 4 + (wave >> 1);
    const int qpos = start + (wave & 1) * 32 + l32;
    bf16x8 qf[4];
    { const bf16_t* qp = QKV + (size_t)(b * SEQ + qpos) * ODD_IN + head * 64 + 8 * half;
#pragma unroll
      for (int ks = 0; ks < 4; ++ks) qf[ks] = *(const bf16x8*)(qp + 16 * ks); }
    f32x16 O[2], negm;
#pragma unroll
    for (int i = 0; i < 16; ++i) negm[i] = 0.f;
#pragma unroll
    for (int eb = 0; eb < 2; ++eb)
#pragma unroll
        for (int i = 0; i < 16; ++i) O[eb][i] = 0.f;
    float m = 0.f, l = 0.f, pmx = 0.f;
    const int vlane = (4 * (lane >> 5) + ((lane & 15) >> 2)) * WA_VSTR + 32 * ((lane >> 4) & 1) + 8 * (lane & 3);
    const int t_lo = start >= 128 ? 0 : (128 - start) >> 6;
    const int t_hi = min(5, (SEQ + 128 - start) >> 6);
    const int nbd = t_hi - t_lo, nt = nbd + 4;
    const int skey = tid >> 3, sch = tid & 7;
    u32x4 k0, v0, k1, v1;
#define WA_LOAD(n, KR, VR) do { const int kr_ = ((n) < nbd) ? b * SEQ + start - 128 + 64 * (t_lo + (n)) : NLAT + b * CTXL + 64 * ((n) - nbd); \
        const bf16_t* rp_ = QKV + (size_t)(kr_ + skey) * ODD_IN + kvh * 64 + sch * 8; KR = *(const u32x4*)(rp_ + 1024); VR = *(const u32x4*)(rp_ + 1280); } while (0)
#define WA_STORE(buf, KR, VR) do { *(LAS u32x4*)(KB[buf] + skey * 144 + sch * 16) = KR; *(LAS u32x4*)(VT[buf] + skey * WA_VSTR + sch * 16) = VR; } while (0)
#define WA_TILE(n, buf) do { if ((n) < nbd) flash_tile<2, true, WA_VSTR>(KB[buf], 144, VT[buf] + vlane, qf, O, negm, m, l, pmx, l32, half, qpos, start - 128 + 64 * (t_lo + (n))); \
        else flash_tile<2, false, WA_VSTR>(KB[buf], 144, VT[buf] + vlane, qf, O, negm, m, l, pmx, l32, half, 0, 0); } while (0)
    WA_LOAD(0, k0, v0); WA_LOAD(1, k1, v1);
    WA_STORE(0, k0, v0);
    __syncthreads();
    for (int n = 0; n < nt; n += 2) {
        if (n + 2 < nt) WA_LOAD(n + 2, k0, v0);
        WA_TILE(n, 0);
        if (n + 1 < nt) WA_STORE(1, k1, v1);
        __syncthreads();
        if (n + 1 >= nt) break;
        if (n + 3 < nt) WA_LOAD(n + 3, k1, v1);
        WA_TILE(n + 1, 1);
        if (n + 2 < nt) WA_STORE(0, k0, v0);
        __syncthreads();
    }
#undef WA_LOAD
#undef WA_STORE
#undef WA_TILE
    const float sk2 = sink[head] * LOG2E;
    l += shx(l, 32, lane);
    float sc;
    { const float mn = fmaxf(m, sk2), al = fexp2(m - mn); sc = al / (l * al + fexp2(sk2 - mn)); }
    bf16_t* op = MIX + (size_t)(b * SEQ + qpos) * DM + head * 64 + 4 * half;
#pragma unroll
    for (int eb = 0; eb < 2; ++eb)
#pragma unroll
        for (int gi = 0; gi < 4; ++gi) {
            const int e0 = 32 * eb + 8 * gi;
            u32x2 w; w.x = pk2(O[eb][4 * gi] * sc, O[eb][4 * gi + 1] * sc); w.y = pk2(O[eb][4 * gi + 2] * sc, O[eb][4 * gi + 3] * sc);
            *(u32x2*)(op + e0) = w;
        }
}

constexpr int CM_VS = 320;
__device__ __forceinline__ void chunk_mlp_units(LAS unsigned char* lds, const bf16_t* __restrict__ P1, const bf16_t* __restrict__ Wsg, const float* __restrict__ sgu_b,
                                                bf16_t* __restrict__ MIX, const int u_first, const int u_step, const int u_end, const int tid, const int wave, const int lane) {
    const int l32 = lane & 31, half = lane >> 5;
    const int pb = wave >> 1, cb0 = (wave & 1) * 2;
    const LAS unsigned char* tb = lds + (8 * half + ((lane & 15) >> 2)) * CM_VS + 32 * ((lane >> 4) & 1) + 8 * (lane & 3) + 64 * cb0;
    u32x4 raw[4];
#define CM_LOADV(u_) do { const int rb_ = (u_) >> 2, g_ = (u_) & 3; _Pragma("unroll") for (int pass = 0; pass < 4; ++pass) \
        raw[pass] = *(const u32x4*)(P1 + (size_t)(rb_ * 128 + pass * 32 + (tid >> 4)) * EVEN_IN + 512 + g_ * 128 + (tid & 15) * 8); } while (0)
    if (u_first < u_end) CM_LOADV(u_first);
    for (int u = u_first; u < u_end; u += u_step) {
        const int rb = u >> 2, g = u & 3, rowbase = rb * 128;
#pragma unroll
        for (int pass = 0; pass < 4; ++pass) {
            const int q = pass * 32 + (tid >> 4), ch = tid & 15;
            float x[8];
#pragma unroll
            for (int k = 0; k < 4; ++k) { x[2 * k] = bf_lo(raw[pass][k]); x[2 * k + 1] = bf_hi(raw[pass][k]); }
            float s = 0.f;
#pragma unroll
            for (int k = 0; k < 8; ++k) s += x[k];
            s += shx(s, 1, lane); s += shx(s, 2, lane); s += shx(s, 4, lane); s += shx(s, 8, lane);
            const float mu = s * (1.0f / 128.0f);
            float v = 0.f;
#pragma unroll
            for (int k = 0; k < 8; ++k) { x[k] -= mu; v += x[k] * x[k]; }
            v += shx(v, 1, lane); v += shx(v, 2, lane); v += shx(v, 4, lane); v += shx(v, 8, lane);
            const float rstd = 1.0f / sqrtf(v * (1.0f / 128.0f) + EPS);
            u32x4 w; w.x = pk2(x[0] * rstd, x[1] * rstd); w.y = pk2(x[2] * rstd, x[3] * rstd); w.z = pk2(x[4] * rstd, x[5] * rstd); w.w = pk2(x[6] * rstd, x[7] * rstd);
            *(LAS u32x4*)(lds + q * CM_VS + ch * 16) = w;
        }
        const int p = 32 * pb + l32;
        const size_t row = (size_t)(rowbase + p);
        const bf16_t* up = P1 + row * EVEN_IN + g * 128 + 32 * cb0 + 4 * half;
        u32x2 uv0[4], uv1[4];
#pragma unroll
        for (int gi = 0; gi < 4; ++gi) { uv0[gi] = *(const u32x2*)(up + 8 * gi); uv1[gi] = *(const u32x2*)(up + 32 + 8 * gi); }
        const float bias = sgu_b[g * 128 + p];
        if (u + u_step < u_end) CM_LOADV(u + u_step);
        __syncthreads();
        f32x16 a0, a1;
#pragma unroll
        for (int i = 0; i < 16; ++i) { a0[i] = 0.f; a1[i] = 0.f; }
        const bf16_t* wp = Wsg + (size_t)(g * 128 + 32 * pb + l32) * 128 + 8 * half;
#pragma unroll
        for (int ks = 0; ks < 8; ++ks) {
            const bf16x8 bw = *(const bf16x8*)(wp + 16 * ks);
            const LAS unsigned char* t0 = tb + 16 * ks * CM_VS;
            const s16x4 lo0 = __builtin_amdgcn_ds_read_tr16_b64_v4i16((LAS s16x4*)t0), hi0 = __builtin_amdgcn_ds_read_tr16_b64_v4i16((LAS s16x4*)(t0 + 4 * CM_VS));
            const s16x4 lo1 = __builtin_amdgcn_ds_read_tr16_b64_v4i16((LAS s16x4*)(t0 + 64)), hi1 = __builtin_amdgcn_ds_read_tr16_b64_v4i16((LAS s16x4*)(t0 + 64 + 4 * CM_VS));
            a0 = MFMA32(__builtin_shufflevector(lo0, hi0, 0, 1, 2, 3, 4, 5, 6, 7), bw, a0);
            a1 = MFMA32(__builtin_shufflevector(lo1, hi1, 0, 1, 2, 3, 4, 5, 6, 7), bw, a1);
        }
        bf16_t* op = MIX + row * DM + g * 128 + 32 * cb0 + 4 * half;
#pragma unroll
        for (int gi = 0; gi < 4; ++gi) {
            const u32x2 u0 = uv0[gi], u1 = uv1[gi];
            u32x2 w0, w1;
            w0.x = pk2(bf_lo(u0.x) * (a0[4 * gi] + bias), bf_hi(u0.x) * (a0[4 * gi + 1] + bias)); w0.y = pk2(bf_lo(u0.y) * (a0[4 * gi + 2] + bias), bf_hi(u0.y) * (a0[4 * gi + 3] + bias));
            w1.x = pk2(bf_lo(u1.x) * (a1[4 * gi] + bias), bf_hi(u1.x) * (a1[4 * gi + 1] + bias)); w1.y = pk2(bf_lo(u1.y) * (a1[4 * gi + 2] + bias), bf_hi(u1.y) * (a1[4 * gi + 3] + bias));
            *(u32x2*)(op + 8 * gi) = w0; *(u32x2*)(op + 32 + 8 * gi) = w1;
        }
        __syncthreads();
    }
#undef CM_LOADV
}

template <bool IN_BF16>
__device__ __forceinline__ void load_row16(const void* src, int lane, f32x4 (&v)[4]) {
    if (IN_BF16) {
        const bf16_t* p = (const bf16_t*)src;
#pragma unroll
        for (int hh = 0; hh < 2; ++hh) { const u32x4 raw = *(const u32x4*)(p + hh * 512 + 8 * lane);
            v[2 * hh] = (f32x4){bf_lo(raw.x), bf_hi(raw.x), bf_lo(raw.y), bf_hi(raw.y)}; v[2 * hh + 1] = (f32x4){bf_lo(raw.z), bf_hi(raw.z), bf_lo(raw.w), bf_hi(raw.w)}; }
    } else {
        const float* p = (const float*)src;
#pragma unroll
        for (int hh = 0; hh < 2; ++hh) { v[2 * hh] = *(const f32x4*)(p + hh * 512 + 8 * lane); v[2 * hh + 1] = *(const f32x4*)(p + hh * 512 + 8 * lane + 4); }
    }
}
template <bool IN_BF16>
__device__ __forceinline__ void norm_rows(const void* __restrict__ lat, const void* __restrict__ ctxp, const float* __restrict__ g, const float* __restrict__ modl,
                                          const int sh_off, const int sc_off, bf16_t* __restrict__ dst, const int nrows, const int gw, const int ngw, const int lane) {
    constexpr int ES = IN_BF16 ? 2 : 4;
    for (int row = gw; row < nrows; row += ngw) {
        const bool isl = row < NLAT;
        const unsigned char* src = isl ? (const unsigned char*)lat + (size_t)row * DM * ES : (const unsigned char*)ctxp + (size_t)(row - NLAT) * DM * ES;
        const float* mrow = modl + (isl ? (row >> 12) : 8) * 6144;
        f32x4 v[4]; load_row16<IN_BF16>(src, lane, v);
        float ss = 0.f;
#pragma unroll
        for (int j = 0; j < 4; ++j) ss += (v[j][0] * v[j][0] + v[j][1] * v[j][1]) + (v[j][2] * v[j][2] + v[j][3] * v[j][3]);
        const float rstd = 1.0f / sqrtf(wave_sum(ss, lane) * (1.0f / DM) + EPS);
#pragma unroll
        for (int hh = 0; hh < 2; ++hh) {
            const int col = hh * 512 + 8 * lane;
            u32x4 w;
#pragma unroll
            for (int q = 0; q < 2; ++q) {
                const f32x4 gg = *(const f32x4*)(g + col + 4 * q), sc = *(const f32x4*)(mrow + sc_off + col + 4 * q), sh = *(const f32x4*)(mrow + sh_off + col + 4 * q);
                const f32x4 o = v[2 * hh + q] * rstd * gg * (sc + 1.0f) + sh;
                if (q == 0) { w.x = pk2(o[0], o[1]); w.y = pk2(o[2], o[3]); } else { w.z = pk2(o[0], o[1]); w.w = pk2(o[2], o[3]); }
            }
            *(u32x4*)(dst + (size_t)row * DM + col) = w;
        }
    }
}

#define XB_TMO      128
#define XB_XCNT(j)  (256  + 64 * (j))
#define XB_XSUB(j)  (1280 + 64 * (j))
#define XB_XGEN(j)  (2304 + 64 * (j))
#define XB_TOP      3328
#define XB_TOPGEN   3392
#define XCD_BAR_WORDS 3456
#define XB_SPIN_CAP (1u << 18)
__device__ __forceinline__ unsigned xb_ld(unsigned* p)              { return __hip_atomic_load(p, __ATOMIC_RELAXED, __HIP_MEMORY_SCOPE_AGENT); }
__device__ __forceinline__ unsigned xb_add(unsigned* p, unsigned v) { return __hip_atomic_fetch_add(p, v, __ATOMIC_RELAXED, __HIP_MEMORY_SCOPE_AGENT); }
__device__ __forceinline__ unsigned xb_xcc_id() { return (unsigned)__builtin_amdgcn_s_getreg((3 << 11) | 20) & 0xFu; }
#define XB_SPIN(cond, bar) do { unsigned _sp = 0; while (cond) { __builtin_amdgcn_s_sleep(1); \
    if ((++_sp & 255u) == 0u) { if (xb_ld(&(bar)[XB_TMO])) break; if (_sp > XB_SPIN_CAP) { atomicAdd(&(bar)[XB_TMO], 1u); break; } } } } while (0)
struct XcdBarrier { unsigned* bar; unsigned x; volatile LAS unsigned* st; };
__device__ __forceinline__ XcdBarrier xcd_barrier_post(unsigned* bar, volatile LAS unsigned* st) {
    XcdBarrier b; b.bar = bar; b.x = xb_xcc_id(); b.st = st;
    if (threadIdx.x == 0) (void)xb_add(&bar[XB_XCNT(b.x)], 1u);
    return b;
}
__device__ __forceinline__ void xcd_barrier_complete(unsigned* bar, unsigned x, unsigned& nloc, unsigned& nx) {
    const unsigned G = gridDim.x * gridDim.y * gridDim.z;
    unsigned sum, cnt, mine, sp = 0u;
    for (;;) {
        sum = 0u; cnt = 0u; mine = 0u;
#pragma unroll
        for (unsigned j = 0; j < 16; ++j) { const unsigned c = xb_ld(&bar[XB_XCNT(j)]); sum += c; cnt += (c > 0u) ? 1u : 0u; mine = (j == x) ? c : mine; }
        if (sum == G) break;
        __builtin_amdgcn_s_sleep(1);
        if ((++sp & 255u) == 0u) { if (xb_ld(&bar[XB_TMO])) break; if (sp > XB_SPIN_CAP) { atomicAdd(&bar[XB_TMO], 1u); break; } }
    }
    nloc = mine > 0u ? mine : 1u; nx = cnt > 0u ? cnt : 1u;
}
__device__ __forceinline__ void xcd_barrier(const XcdBarrier& b) {
    asm volatile("s_waitcnt vmcnt(0)" ::: "memory");
    __syncthreads();
    if (threadIdx.x == 0) {
        unsigned* bar = b.bar;
        __builtin_amdgcn_s_waitcnt(0);
        unsigned nloc = b.st[0], nx = b.st[1];
        if (nloc == 0u) { xcd_barrier_complete(bar, b.x, nloc, nx); b.st[0] = nloc; b.st[1] = nx; }
        const unsigned old = xb_add(&bar[XB_XSUB(b.x)], 1u);
        const unsigned gen = old / nloc;
        if (old + 1u == (gen + 1u) * nloc) {
            __builtin_amdgcn_fence(__ATOMIC_RELEASE, "agent");
            asm volatile("s_waitcnt vmcnt(0)" ::: "memory");
            const unsigned og = xb_add(&bar[XB_TOP], 1u);
            const unsigned tg = og / nx;
            if (og + 1u == (tg + 1u) * nx) xb_add(&bar[XB_TOPGEN], 1u);
            else XB_SPIN(xb_ld(&bar[XB_TOPGEN]) == tg, bar);
            __builtin_amdgcn_fence(__ATOMIC_ACQUIRE, "agent");
            xb_add(&bar[XB_XGEN(b.x)], 1u);
            asm volatile("s_waitcnt vmcnt(0)" ::: "memory");
        } else {
            XB_SPIN(xb_ld(&bar[XB_XGEN(b.x)]) == gen, bar);
            __builtin_amdgcn_fence(__ATOMIC_ACQUIRE, "agent");
            asm volatile("s_waitcnt vmcnt(0)" ::: "memory");
        }
    }
    __syncthreads();
}

struct Params { const float* in[23]; float* out; unsigned char* ws; int ph_lo, ph_hi; };
enum { I_X = 0, I_C, I_CTX, I_CCTX, I_ADA_W, I_ADA_B, I_N1G, I_N2G, I_FFN_IN, I_FFN_OUT, I_EV_IN, I_EV_OUT, I_SGU_W, I_SGU_B, I_LQ1, I_LK1, I_LQ2, I_LK2, I_SUBLN, I_OD_QKV, I_OD_OUT, I_SINK, I_FINAL_G };
constexpr int NPHASE = 16;
#define DUP_MLP 0
#define EXTRA_SYNCS 0
#define DUP_MASK 0u
#define PROBE 0
#ifdef ONLY_PH
#define PH_ON(k) ((ONLY_PH) == (k))
#else
#define PH_ON(k) true
#endif

__global__ void __launch_bounds__(512, 2) mega_fwd(Params P) {
    extern __shared__ __attribute__((aligned(16))) unsigned char lds_raw[];
    LAS unsigned char* lds = (LAS unsigned char*)lds_raw;
    cg::grid_group grid = cg::this_grid();
    { volatile LAS unsigned* st0 = (volatile LAS unsigned*)(lds + 131072); if (threadIdx.x < 4) st0[threadIdx.x] = 0u; }
    __syncthreads();
    const XcdBarrier xbar = xcd_barrier_post((unsigned*)(P.ws + WS_BAR), (volatile LAS unsigned*)(lds + 131072));
    const int bid = blockIdx.x;
    unsigned char* ws = P.ws;
    bf16_t* WE_IN = (bf16_t*)(ws + WS_WE_IN); bf16_t* WE_OUT = (bf16_t*)(ws + WS_WE_OUT); bf16_t* WF_IN = (bf16_t*)(ws + WS_WF_IN); bf16_t* WF_OUT = (bf16_t*)(ws + WS_WF_OUT);
    bf16_t* WO_QKV = (bf16_t*)(ws + WS_WO_QKV); bf16_t* WO_OUT = (bf16_t*)(ws + WS_WO_OUT); bf16_t* SGU = (bf16_t*)(ws + WS_SGU);
    float* MOD = (float*)(ws + WS_MOD); float* ROPE = (float*)(ws + WS_ROPE); float* HC = (float*)(ws + WS_HC);
    bf16_t* ABUF = (bf16_t*)(ws + WS_A); bf16_t* MIX = (bf16_t*)(ws + WS_MIX); bf16_t* BIG = (bf16_t*)(ws + WS_BIG); bf16_t* HB = (bf16_t*)(ws + WS_HB); float* PART = (float*)(ws + WS_PART);
    const float* X = P.in[I_X]; const float* CTX = P.in[I_CTX]; float* OUT = P.out;

#if PROBE
    unsigned long long t_prev = __builtin_amdgcn_s_memrealtime(), cA = 0, cB = 0, cC = 0, cD = 0;
#endif
    for (int pi = 2 * P.ph_lo; pi < 2 * P.ph_hi; ++pi) {
        const int ph = pi >> 1;
        if ((pi & 1) && !((DUP_MASK >> ph) & 1u)) continue;
        int G = gridDim.x; asm volatile("" : "+s"(G));
        int tid = threadIdx.x; asm volatile("" : "+v"(tid));
        const int lane = tid & 63, wave = __builtin_amdgcn_readfirstlane(tid >> 6);
        const int gw = bid * 8 + wave, ngw = G * 8;
        if (ph == 0 && PH_ON(0)) {
            LAS float* scr = (LAS float*)lds; LAS float* red = (LAS float*)(lds + 9 * 1024 * 4);
            for (int it = bid; it < 192; it += G) {
                const int l = it / 96, n0 = (it % 96) * 64;
                for (int idx = tid; idx < 9216; idx += 512) { const int r = idx >> 10, k = idx & 1023; const float cv = r < 8 ? P.in[I_C][r * 1024 + k] : P.in[I_CCTX][k];
                    scr[idx] = cv / (1.0f + __expf(-cv)); }
                __syncthreads();
                float acc[9];
#pragma unroll
                for (int r = 0; r < 9; ++r) acc[r] = 0.f;
                const float* Wp = P.in[I_ADA_W] + (size_t)l * 1024 * 6144 + (size_t)(wave * 128) * 6144 + n0 + lane;
#pragma unroll 4
                for (int kk = 0; kk < 128; ++kk) { const float wv = Wp[(size_t)kk * 6144];
#pragma unroll
                    for (int r = 0; r < 9; ++r) acc[r] += scr[r * 1024 + wave * 128 + kk] * wv; }
#pragma unroll
                for (int r = 0; r < 9; ++r) red[(wave * 9 + r) * 64 + lane] = acc[r];
                __syncthreads();
                for (int idx = tid; idx < 576; idx += 512) { const int r = idx >> 6, cc = idx & 63; float s = 0.f;
#pragma unroll
                    for (int w = 0; w < 8; ++w) s += red[(w * 9 + r) * 64 + cc];
                    MOD[(size_t)(l * 9 + r) * 6144 + n0 + cc] = s + P.in[I_ADA_B][l * 6144 + n0 + cc]; }
                __syncthreads();
            }
            for (int idx = bid * 512 + tid; idx < 1024; idx += G * 512) { const int pos = idx >> 4, i = idx & 15;
                const float inv = fexp2(-(float)i * (13.287712379549449f / 16.0f)); const float rev = (float)pos * inv * 0.15915494309189535f;
                ROPE[idx] = __builtin_amdgcn_cosf(rev); ROPE[1024 + idx] = __builtin_amdgcn_sinf(rev); }
            for (int idx = bid * 512 + tid; idx < 4 * 128 * 128 / 2; idx += G * 512) { const f32x2 v = *(const f32x2*)(P.in[I_SGU_W] + 2 * idx); ((unsigned*)SGU)[idx] = pk2(v.x, v.y); }
            LAS float* tscr = (LAS float*)(lds + wave * 8448);
            constexpr int T0 = 16 * 80, T1 = 16 * 32, T2 = 16 * 176, T3 = 44 * 32, T4 = 16 * 48, T5 = 16 * 32;
            constexpr int NIT = T0 + T1 + 2 * T2 + 2 * T3 + T4 + T5;
            for (int it = gw; it < NIT; it += ngw) {
                int r = it;
                if (r < T0) { transpose_mat<false>(P.in[I_EV_IN], DM, EVEN_IN, WE_IN, r, tscr, lane); continue; } r -= T0;
                if (r < T1) { transpose_mat<false>(P.in[I_EV_OUT], DM, DM, WE_OUT, r, tscr, lane); continue; } r -= T1;
                if (r < T2) { transpose_mat<true>(P.in[I_FFN_IN], DM, 2 * FFH, WF_IN, r, tscr, lane); continue; } r -= T2;
                if (r < T2) { transpose_mat<true>(P.in[I_FFN_IN] + (size_t)DM * 2 * FFH, DM, 2 * FFH, WF_IN + (size_t)2 * FFH * DM, r, tscr, lane); continue; } r -= T2;
                if (r < T3) { transpose_mat<false>(P.in[I_FFN_OUT], FFH, DM, WF_OUT, r, tscr, lane); continue; } r -= T3;
                if (r < T3) { transpose_mat<false>(P.in[I_FFN_OUT] + (size_t)FFH * DM, FFH, DM, WF_OUT + (size_t)DM * FFH, r, tscr, lane); continue; } r -= T3;
                if (r < T4) { transpose_mat<false>(P.in[I_OD_QKV], DM, ODD_IN, WO_QKV, r, tscr, lane); continue; } r -= T4;
                transpose_mat<false>(P.in[I_OD_OUT], DM, DM, WO_OUT, r, tscr, lane);
            }
        } else if ((ph == 1 || ph == 5 || ph == 8 || ph == 12) && PH_ON(1)) {
            const int l = ph >= 8 ? 1 : 0; const bool first = (ph == 1 || ph == 8);
            const float* ng = P.in[first ? I_N1G : I_N2G] + l * DM; const float* md = MOD + (size_t)l * 9 * 6144;
            if (ph == 1) norm_rows<false>(X, CTX, ng, md, 0, 1024, ABUF, MROWS, gw, ngw, lane);
            else {
                norm_rows<true>(HB, HB + (size_t)NLAT * DM, ng, md, first ? 0 : 3072, first ? 1024 : 4096, ABUF, NLAT, gw, ngw, lane);
                if (ph != 12) {
                    const int npart = ph == 5 ? 4 : 2; const float* fg = MOD + (size_t)8 * 6144 + (ph == 5 ? 2048 : 5120);
                    const float* mrow = md + 8 * 6144; const int sh_off = first ? 0 : 3072, sc_off = first ? 1024 : 4096;
                    for (int r = gw; r < NCTX; r += ngw) {
                        f32x4 v[4];
                        if (ph == 5) load_row16<false>(CTX + (size_t)r * DM, lane, v); else load_row16<true>(HB + (size_t)(NLAT + r) * DM, lane, v);
                        f32x4 a[4];
#pragma unroll
                        for (int j = 0; j < 4; ++j) a[j] = (f32x4){0.f, 0.f, 0.f, 0.f};
                        for (int k = 0; k < npart; ++k) { f32x4 p[4]; load_row16<false>(PART + ((size_t)k * NCTX + r) * DM, lane, p);
#pragma unroll
                            for (int j = 0; j < 4; ++j) a[j] += p[j]; }
                        f32x4 gg[4]; load_row16<false>(fg, lane, gg);
                        float ss = 0.f; u32x4 hw[2];
#pragma unroll
                        for (int j = 0; j < 4; ++j) { const f32x4 h = v[j] + gg[j] * a[j]; const unsigned w0 = pk2(h[0], h[1]), w1 = pk2(h[2], h[3]);
                            if (j & 1) { hw[j >> 1].z = w0; hw[j >> 1].w = w1; } else { hw[j >> 1].x = w0; hw[j >> 1].y = w1; }
                            v[j] = (f32x4){bf_lo(w0), bf_hi(w0), bf_lo(w1), bf_hi(w1)};
                            ss += (v[j][0] * v[j][0] + v[j][1] * v[j][1]) + (v[j][2] * v[j][2] + v[j][3] * v[j][3]); }
                        *(u32x4*)(HB + (size_t)(NLAT + r) * DM + 8 * lane) = hw[0]; *(u32x4*)(HB + (size_t)(NLAT + r) * DM + 512 + 8 * lane) = hw[1];
                        const float rstd = 1.0f / sqrtf(wave_sum(ss, lane) * (1.0f / DM) + EPS);
#pragma unroll
                        for (int hh = 0; hh < 2; ++hh) {
                            const int col = hh * 512 + 8 * lane; u32x4 w;
#pragma unroll
                            for (int q = 0; q < 2; ++q) {
                                const f32x4 g4 = *(const f32x4*)(ng + col + 4 * q), sc = *(const f32x4*)(mrow + sc_off + col + 4 * q), sh = *(const f32x4*)(mrow + sh_off + col + 4 * q);
                                const f32x4 o = v[2 * hh + q] * rstd * g4 * (sc + 1.0f) + sh;
                                if (q == 0) { w.x = pk2(o[0], o[1]); w.y = pk2(o[2], o[3]); } else { w.z = pk2(o[0], o[1]); w.w = pk2(o[2], o[3]); }
                            }
                            *(u32x4*)(ABUF + (size_t)(NLAT + r) * DM + col) = w;
                        }
                    }
                }
            }
        } else if ((ph == 2 || ph == 9) && PH_ON(2)) {
            const bool ev = ph == 2;
            pg8::Gemm g{ABUF, ev ? WE_IN : WO_QKV, MROWS, ev ? EVEN_IN : ODD_IN, DM, DM}; pg8::StaticOrder S; S.init(g.M, g.N, G, bid);
            pg8::EpiQKV E{BIG, g.N, ev ? 1024 : 0, ev ? 1024 : 0, ev ? 2048 : 1280, ev ? 1536 : 1024, ROPE};
            pg8::gemm_phase<pg8::EpiQKV, pg8::StaticOrder, true, true>(lds, g, S, E, tid);
        } else if (ph == 3 && PH_ON(3)) {
            float lam;
            { const float d1 = wave_sum(P.in[I_LQ1][lane] * P.in[I_LK1][lane], lane), d2 = wave_sum(P.in[I_LQ2][lane] * P.in[I_LK2][lane], lane); lam = __expf(d1) - __expf(d2) + 0.2f; }
            for (int it = bid; it < 1088; it += G) {
                if (it < 1024) {
                    const int uid = (G == 256) ? (((it >> 8) * 8 + (bid & 7)) * 32 + (bid >> 3)) : it;
                    const int b = uid >> 7, h = (uid >> 5) & 3, qb = uid & 31;
                    diff_attn_unit(lds, BIG, MIX, P.in[I_SUBLN], lam, 0.8f, b * SEQ + qb * 128, h, b * SEQ, 64, NLAT + b * CTXL, 68, tid, wave, lane);
                } else if (it < 1088) { const int u = it - 1024, b = u >> 3, h = (u >> 1) & 3, qb = u & 1;
                    diff_attn_unit(lds, BIG, MIX, P.in[I_SUBLN], lam, 0.8f, NLAT + b * CTXL + qb * 128, h, 0, 0, NLAT + b * CTXL, 4, tid, wave, lane);
                }
            }
            {
                int tid2 = threadIdx.x; asm volatile("" : "+v"(tid2));
                const int lane2 = tid2 & 63, wave2 = __builtin_amdgcn_readfirstlane(tid2 >> 6);
                chunk_mlp_units(lds, BIG, SGU, P.in[I_SGU_B], MIX, (bid + 192) % G, G, 1088, tid2, wave2, lane2);
            }
        } else if ((ph == 4 || ph == 7 || ph == 11 || ph == 14) && PH_ON(4)) {
            const int l = ph >= 8 ? 1 : 0; const bool ffn = (ph == 7 || ph == 14);
            const int KK = ffn ? FFH : DM;
            pg8::Gemm g{ffn ? BIG : MIX, ffn ? WF_OUT + (size_t)l * DM * FFH : (l ? WO_OUT : WE_OUT), NLAT, DM, KK, KK}; pg8::StaticOrder S; S.init(g.M, g.N, G, bid);
            const float* gt = MOD + (size_t)l * 9 * 6144 + (ffn ? 5120 : 2048);
            if (ph == 4) { pg8::EpiRes<true> E{X, CTX, HB, gt}; pg8::gemm_phase<pg8::EpiRes<true>, pg8::StaticOrder, true, true>(lds, g, S, E, tid); }
            else { pg8::EpiRes<false> E{nullptr, nullptr, HB, gt}; pg8::gemm_phase<pg8::EpiRes<false>, pg8::StaticOrder, true, true>(lds, g, S, E, tid); }
            if (l == 0) {
                const int nK = ffn ? 2 : 4;
                pg8::Gemm gc{g.A, g.Bt, MROWS, DM, KK / nK, KK}; pg8::SplitOrder SC{NLAT / 256, NCTX / 256, DM / 256, nK, G, bid};
                pg8::EpiPart EC{PART};
                pg8::gemm_phase<pg8::EpiPart, pg8::SplitOrder, true, true>(lds, gc, SC, EC, tid);
            }
        } else if ((ph == 6 || ph == 13) && PH_ON(6)) {
            const int l = ph == 13 ? 1 : 0;
            pg8::Gemm g{ABUF, WF_IN + (size_t)l * 2 * FFH * DM, l ? NLAT : MROWS, 2 * FFH, DM, DM}; pg8::StaticOrder S; S.init(g.M, g.N, G, bid);
            pg8::EpiSwiglu E{BIG};
            pg8::gemm_phase<pg8::EpiSwiglu, pg8::StaticOrder, true, true>(lds, g, S, E, tid);
        } else if (ph == 10 && PH_ON(10)) {
            for (int it = bid; it < 2048; it += G) win_attn_unit(lds, BIG, MIX, P.in[I_SINK], it >> 8, (it >> 6) & 3, (it & 63) * 64, tid, wave, lane);
        } else if (ph == 15 && PH_ON(15)) {
            const float* fg = P.in[I_FINAL_G];
            for (int row = gw; row < NLAT; row += ngw) {
                f32x4 v[4]; load_row16<true>(HB + (size_t)row * DM, lane, v);
                float ss = 0.f;
#pragma unroll
                for (int j = 0; j < 4; ++j) ss += (v[j][0] * v[j][0] + v[j][1] * v[j][1]) + (v[j][2] * v[j][2] + v[j][3] * v[j][3]);
                const float rstd = 1.0f / sqrtf(wave_sum(ss, lane) * (1.0f / DM) + EPS);
#pragma unroll
                for (int j = 0; j < 4; ++j) { const int col = (j >> 1) * 512 + 8 * lane + 4 * (j & 1); *(f32x4*)(OUT + (size_t)row * DM + col) = v[j] * rstd * *(const f32x4*)(fg + col); }
            }
        }
#if PROBE
        grid.sync();
        { const unsigned long long t_now = __builtin_amdgcn_s_memrealtime(); const unsigned long long d = t_now - t_prev; t_prev = t_now;
          if (ph == 3) cA += d; else if (ph == 10) cC += d; else if (ph == 2 || ph == 4 || ph == 6 || ph == 7 || ph == 9 || ph == 11 || ph == 13 || ph == 14) cB += d; else cD += d; }
#else
        if (pi + 1 < 2 * P.ph_hi) { if (P.ph_lo < 0) grid.sync(); xcd_barrier(xbar); }
#endif
    }
    for (int k = 0; k < EXTRA_SYNCS; ++k) xcd_barrier(xbar);
#if PROBE
    { const float v1 = (float)(PROBE == 1 ? cA : cC) * 0.01f * 100.0f, v2 = (float)(PROBE == 1 ? cB : cD) * 0.01f;
      if (bid == 0 && threadIdx.x == 0) OUT[0] = v1;
      for (int i = bid * 512 + threadIdx.x; i < 1048576; i += (int)gridDim.x * 512) OUT[1 + i] = v2; }
#endif
}

extern "C" void kernel_launch(void* const* d_in, const int* in_sizes, int n_in, void* d_out, int out_size, void* d_ws, size_t ws_size, hipStream_t stream) {
    static int grid = 0;
    if (grid == 0) {
        if (n_in != 23 || ws_size < WS_END) { fprintf(stderr, "kernel_launch: unexpected n_in %d / ws %zu (need %zu)\n", n_in, ws_size, (size_t)WS_END); grid = -1; return; }
        int dev = 0, cus = 0, per_cu = 0;
        (void)hipGetDevice(&dev);
        (void)hipDeviceGetAttribute(&cus, hipDeviceAttributeMultiprocessorCount, dev);
        if (hipFuncSetAttribute((const void*)mega_fwd, hipFuncAttributeMaxDynamicSharedMemorySize, LDS_BYTES) != hipSuccess) fprintf(stderr, "kernel_launch: hipFuncSetAttribute failed\n");
        if (hipOccupancyMaxActiveBlocksPerMultiprocessor(&per_cu, (const void*)mega_fwd, 512, LDS_BYTES) != hipSuccess || per_cu < 1) { fprintf(stderr, "kernel_launch: occupancy query gave %d\n", per_cu); per_cu = 1; }
        (void)hipGetLastError();
        grid = cus * (per_cu > 1 ? 1 : per_cu);
        if (grid <= 0) grid = 256;
    }
    if (grid < 0) return;
    if (hipMemsetAsync((unsigned char*)d_ws + WS_BAR, 0, 16384, stream) != hipSuccess) fprintf(stderr, "kernel_launch: hipMemsetAsync failed\n");
    Params p{};
    for (int i = 0; i < 23; ++i) p.in[i] = (const float*)d_in[i];
    p.out = (float*)d_out; p.ws = (unsigned char*)d_ws; p.ph_lo = 0; p.ph_hi = NPHASE;
    void* args[] = {&p};
    hipError_t e = hipLaunchCooperativeKernel((const void*)mega_fwd, dim3(grid), dim3(512), args, LDS_BYTES, stream);
    if (e != hipSuccess) fprintf(stderr, "kernel_launch: cooperative launch failed: %s (grid %d)\n", hipGetErrorString(e), grid);
}
```

```cpp
#include <hip/hip_runtime.h>
#include <hip/hip_cooperative_groups.h>
#include <cstdio>
#include <cstdint>
namespace cg = cooperative_groups;

#define LAS __attribute__((address_space(3)))
typedef unsigned short bf16_t;
typedef short bf16x8 __attribute__((ext_vector_type(8)));
typedef float f32x4 __attribute__((ext_vector_type(4)));
typedef float f32x2 __attribute__((ext_vector_type(2)));
typedef float f32x16 __attribute__((ext_vector_type(16)));
typedef unsigned u32x4 __attribute__((ext_vector_type(4)));
typedef unsigned u32x2 __attribute__((ext_vector_type(2)));
typedef __bf16 bf16v2 __attribute__((ext_vector_type(2)));

constexpr int DM = 1024, NB = 8, SEQ = 4096, NLAT = NB * SEQ, CTXL = 256, NCTX = NB * CTXL, MROWS = NLAT + NCTX;
constexpr int FFH = 2816, EVEN_IN = 2560, ODD_IN = 1536;
constexpr float EPS = 1e-6f;
constexpr float LOG2E = 1.4426950408889634f;
constexpr float QSCALE = 0.125f * LOG2E;
constexpr float NEGB = -1e30f;

constexpr size_t WS_WE_IN = 0;
constexpr size_t WS_WE_OUT = WS_WE_IN + (size_t)EVEN_IN * DM * 2;
constexpr size_t WS_WF_IN = WS_WE_OUT + (size_t)DM * DM * 2;
constexpr size_t WS_WF_OUT = WS_WF_IN + 2 * (size_t)(2 * FFH) * DM * 2;
constexpr size_t WS_WO_QKV = WS_WF_OUT + 2 * (size_t)DM * FFH * 2;
constexpr size_t WS_WO_OUT = WS_WO_QKV + (size_t)ODD_IN * DM * 2;
constexpr size_t WS_SGU = WS_WO_OUT + (size_t)DM * DM * 2;
constexpr size_t WS_MOD = WS_SGU + 4 * 128 * 128 * 2;
constexpr size_t WS_ROPE = WS_MOD + 2 * 9 * 6144 * 4;
constexpr size_t WS_HC = WS_ROPE + 8192;
constexpr size_t WS_A = WS_HC + (size_t)NCTX * DM * 4;
constexpr size_t WS_MIX = WS_A + (size_t)MROWS * DM * 2;
constexpr size_t WS_BIG = WS_MIX + (size_t)MROWS * DM * 2;
constexpr size_t WS_HB = WS_BIG + (size_t)MROWS * FFH * 2;
constexpr size_t WS_PART = WS_HB + (size_t)MROWS * DM * 2;
constexpr size_t WS_BAR = WS_PART + 4 * (size_t)NCTX * DM * 4;
constexpr size_t WS_END = WS_BAR + 16384;

constexpr int LDS_BYTES = 131072 + 16;

__device__ __forceinline__ unsigned pk2(float lo, float hi) { f32x2 v = {lo, hi}; bf16v2 b = __builtin_convertvector(v, bf16v2); return __builtin_bit_cast(unsigned, b); }
__device__ __forceinline__ float bf_lo(unsigned w) { return __uint_as_float(w << 16); }
__device__ __forceinline__ float bf_hi(unsigned w) { return __uint_as_float(w & 0xffff0000u); }
__device__ __forceinline__ float wave_sum(float v) {
#pragma unroll
    for (int o = 1; o < 64; o <<= 1) v += __shfl_xor(v, o);
    return v;
}
__device__ __forceinline__ float fexp2(float x) { return __builtin_amdgcn_exp2f(x); }

namespace pg8 {
#define PG8_LAS __attribute__((address_space(3)))
constexpr int BM = 256, BK = 64, HALF = 128, HTB = HALF * BK * 2, STAGE_BYTES = 8 * HTB, NXCD = 8, WGM = 8;
__host__ __device__ __forceinline__ int lds_byte(int r, int c) { const int st = (r >> 4) * 2 + (c >> 5), rr = r & 15, cc = c & 31, ob = rr * 64 + cc * 2; return st * 1024 + (ob ^ (((ob >> 9) & 1) << 5)); }
__host__ __device__ __forceinline__ void stage_rc(int b, int& R, int& C) { const int st = b / 1024, sb = b % 1024, swz = sb ^ (((sb >> 9) & 1) << 5); R = (st >> 1) * 16 + swz / 64; C = (st & 1) * 32 + (swz % 64) / 2; }
__host__ __device__ __forceinline__ int perm32(int rho) { const int n = rho >> 4, i = rho & 15; return 8 * (i >> 2) + 4 * n + (i & 3); }

struct Unit { int pm, pn, pk; };
struct Gemm { const bf16_t* A; const bf16_t* Bt; int M, N, K, ld; };

struct StaticOrder {
    int nM, nN, nwg, G, c;
    __host__ __device__ void init(int M, int N, int G_, int c_) { nM = M / BM; nN = N / BM; nwg = nM * nN; G = G_; c = c_; }
    __host__ __device__ bool next(int i, Unit& u) const {
        const long L = (long)i * G + c; if (L >= nwg) return false;
        int wgid = (int)L; { const int q = nwg / NXCD, r = nwg % NXCD, xcd = wgid % NXCD, off = wgid / NXCD; wgid = (xcd < r ? xcd * (q + 1) : r * (q + 1) + (xcd - r) * q) + off; }
        const int nig = WGM * nN, gid = wgid / nig, fm = gid * WGM, gsz = (nM - fm) < WGM ? (nM - fm) : WGM;
        u.pm = fm + ((wgid % nig) % gsz); u.pn = (wgid % nig) / gsz; u.pk = 0; return true;
    }
    __device__ __forceinline__ void a_ready(const Unit&) const {}
    __device__ __forceinline__ void done(const Unit&) const {}
};

struct SplitOrder {
    int pm0, nM, nN, nK, G, c;
    __device__ bool next(int i, Unit& u) const {
        const long L = (long)i * G + c; if (L >= (long)nM * nN * nK) return false;
        const int l = (int)L; u.pk = l % nK; const int r = l / nK; u.pn = r % nN; u.pm = pm0 + r / nN; return true;
    }
    __device__ __forceinline__ void a_ready(const Unit&) const {}
    __device__ __forceinline__ void done(const Unit&) const {}
};

__device__ __forceinline__ f32x2 gelu_pk(f32x2 v) {
    const f32x2 av = __builtin_elementwise_abs(v), d = av * 0.2316418882f + 1.0f;
    f32x2 t; t.x = __builtin_amdgcn_rcpf(d.x); t.y = __builtin_amdgcn_rcpf(d.y);
    f32x2 q = t * 0.5307027145f + (-0.7265760135f); q = q * t + 0.7107068705f; q = q * t + (-0.142248368f); q = q * t + 0.127414796f; q = q * t;
    const f32x2 s = (v * v) * (-0.72134752044f);
    f32x2 e; e.x = __builtin_amdgcn_exp2f(s.x); e.y = __builtin_amdgcn_exp2f(s.y);
    const f32x2 m = v * (q * e), r = v - m;
    f32x2 o; o.x = v.x < 0.f ? m.x : r.x; o.y = v.y < 0.f ? m.y : r.y; return o;
}
__device__ __forceinline__ f32x4 gelu4(f32x4 v) { f32x2 a = gelu_pk((f32x2){v[0], v[1]}), b = gelu_pk((f32x2){v[2], v[3]}); return (f32x4){a.x, a.y, b.x, b.y}; }


struct EpiQKV {
    static constexpr bool PERM = false, AFTER_DRAIN = false;
    bf16_t* O; int ldc, gelu_end, rope_lo, rope_hi, q_hi; const float* rope;
    __device__ __forceinline__ void operator()(const f32x4 (&acc)[2][2][4][2], const Unit& u, int wr, int wc, int fr, int fq) const {
#pragma unroll
        for (int ai = 0; ai < 2; ++ai)
#pragma unroll
            for (int m = 0; m < 4; ++m) {
                const int row = u.pm * BM + ai * HALF + wr * 64 + m * 16 + fr;
                const bool lat = row < NLAT; const int t = row & (SEQ - 1); const int pos = (wc & 1) ? (t & 63) : (t >> 6);
                bf16_t* rowp = O + (size_t)row * ldc + u.pn * BM + wc * 32 + 4 * fq;
#pragma unroll
                for (int bj = 0; bj < 2; ++bj) {
                    const int colb = u.pn * BM + bj * HALF;
                    f32x4 v0 = acc[ai][bj][m][0], v1 = acc[ai][bj][m][1];
                    if (colb < gelu_end) { v0 = gelu4(v0); v1 = gelu4(v1); }
                    else if (colb >= rope_lo && colb < rope_hi) {
                        if (lat) {
                            const f32x4 c4 = *(const f32x4*)(rope + pos * 16 + 4 * fq), s4 = *(const f32x4*)(rope + 1024 + pos * 16 + 4 * fq);
                            const f32x4 o0 = v0 * c4 - v1 * s4, o1 = v1 * c4 + v0 * s4; v0 = o0; v1 = o1;
                        }
                        if (colb < q_hi) { v0 = v0 * QSCALE; v1 = v1 * QSCALE; }
                    }
                    u32x2 w0, w1; w0.x = pk2(v0[0], v0[1]); w0.y = pk2(v0[2], v0[3]); w1.x = pk2(v1[0], v1[1]); w1.y = pk2(v1[2], v1[3]);
                    *(u32x2*)(rowp + bj * HALF) = w0; *(u32x2*)(rowp + bj * HALF + 16) = w1;
                }
            }
    }
};
template <bool BASE_F32>
struct EpiRes {
    static constexpr bool PERM = true, AFTER_DRAIN = false;
    const float* base_lat; const float* base_ctx; bf16_t* hb; const float* gate;
    __device__ __forceinline__ void operator()(const f32x4 (&acc)[2][2][4][2], const Unit& u, int wr, int wc, int fr, int fq) const {
        const int row0 = u.pm * BM; const bool lat = row0 < NLAT; const int ridx = lat ? (row0 >> 12) : 8;
        const int cb = u.pn * BM + wc * 32 + 8 * fq;
        bf16_t* hrow = hb + (size_t)(row0 + wr * 64 + fr) * DM + cb;
        const float* brow = (lat ? base_lat + (size_t)row0 * DM : base_ctx + (size_t)(row0 - NLAT) * DM) + (size_t)(wr * 64 + fr) * DM + cb;
#pragma unroll
        for (int bj = 0; bj < 2; ++bj) {
            const int co = bj * HALF;
            const f32x4 g0 = *(const f32x4*)(gate + ridx * 6144 + cb + co), g1 = *(const f32x4*)(gate + ridx * 6144 + cb + co + 4);
#pragma unroll
            for (int ai = 0; ai < 2; ++ai) {
                f32x4 b0[4], b1[4];
                if (BASE_F32) {
#pragma unroll
                    for (int m = 0; m < 4; ++m) { const float* p = brow + (size_t)(ai * HALF + m * 16) * DM + co; b0[m] = __builtin_nontemporal_load((const f32x4*)p); b1[m] = __builtin_nontemporal_load((const f32x4*)(p + 4)); }
                } else {
                    u32x4 raw[4];
#pragma unroll
                    for (int m = 0; m < 4; ++m) raw[m] = *(const u32x4*)(hrow + (size_t)(ai * HALF + m * 16) * DM + co);
#pragma unroll
                    for (int m = 0; m < 4; ++m) { b0[m] = (f32x4){bf_lo(raw[m].x), bf_hi(raw[m].x), bf_lo(raw[m].y), bf_hi(raw[m].y)}; b1[m] = (f32x4){bf_lo(raw[m].z), bf_hi(raw[m].z), bf_lo(raw[m].w), bf_hi(raw[m].w)}; }
                }
#pragma unroll
                for (int m = 0; m < 4; ++m) {
                    const f32x4 h0 = b0[m] + g0 * acc[ai][bj][m][0], h1 = b1[m] + g1 * acc[ai][bj][m][1];
                    u32x4 w; w.x = pk2(h0[0], h0[1]); w.y = pk2(h0[2], h0[3]); w.z = pk2(h1[0], h1[1]); w.w = pk2(h1[2], h1[3]);
                    *(u32x4*)(hrow + (size_t)(ai * HALF + m * 16) * DM + co) = w;
                }
            }
        }
    }
};
struct EpiPart {
    static constexpr bool PERM = false, AFTER_DRAIN = false;
    float* part;
    __device__ __forceinline__ void operator()(const f32x4 (&acc)[2][2][4][2], const Unit& u, int wr, int wc, int fr, int fq) const {
        float* base = part + ((size_t)u.pk * NCTX + (size_t)(u.pm * BM - NLAT + wr * 64 + fr)) * DM + u.pn * BM + wc * 32 + 4 * fq;
#pragma unroll
        for (int ai = 0; ai < 2; ++ai)
#pragma unroll
            for (int m = 0; m < 4; ++m)
#pragma unroll
                for (int bj = 0; bj < 2; ++bj)
#pragma unroll
                    for (int n = 0; n < 2; ++n) *(f32x4*)(base + (size_t)(ai * HALF + m * 16) * DM + bj * HALF + n * 16) = acc[ai][bj][m][n];
    }
};
struct EpiSwiglu {
    static constexpr bool PERM = true, AFTER_DRAIN = false;
    bf16_t* H;
    __device__ __forceinline__ void operator()(const f32x4 (&acc)[2][2][4][2], const Unit& u, int wr, int wc, int fr, int fq) const {
#pragma unroll
        for (int ai = 0; ai < 2; ++ai)
#pragma unroll
            for (int m = 0; m < 4; ++m) {
                const int row = u.pm * BM + ai * HALF + wr * 64 + m * 16 + fr;
                bf16_t* p = H + (size_t)row * FFH + u.pn * HALF + wc * 32 + 8 * fq;
                float r[8];
#pragma unroll
                for (int n = 0; n < 2; ++n)
#pragma unroll
                    for (int j = 0; j < 4; ++j) { const float g = acc[ai][0][m][n][j], uu = acc[ai][1][m][n][j];
                        r[4 * n + j] = g * __builtin_amdgcn_rcpf(1.0f + __builtin_amdgcn_exp2f(-g * LOG2E)) * uu; }
                u32x4 w; w.x = pk2(r[0], r[1]); w.y = pk2(r[2], r[3]); w.z = pk2(r[4], r[5]); w.w = pk2(r[6], r[7]);
                *(u32x4*)p = w;
            }
    }
};

template <class Epi, class Sched, bool ALIGN_EPI = false, bool SP2 = false>
__device__ __forceinline__ void gemm_phase(PG8_LAS unsigned char* lds, const Gemm g, const Sched& S, const Epi& E, const int tid) {
    const int wid = __builtin_amdgcn_readfirstlane(tid >> 6), lane = tid & 63, wr = wid >> 2, wc = wid & 3, fr = lane & 15, fq = lane >> 4;
    const int K = g.K, ld = g.ld, nt = K / BK;
    unsigned voffA[2], voffB[2];
#pragma unroll
    for (int i = 0; i < 2; ++i) { int R, C; stage_rc(tid * 16 + i * 8192, R, C); const int Rb = Epi::PERM ? ((R & ~31) + perm32(R & 31)) : R;
        voffA[i] = (unsigned)(R * ld + C) * 2u; voffB[i] = (unsigned)(Rb * ld + C) * 2u; }
    const size_t kstep = (size_t)(BK * 2);
    const size_t hstep = (size_t)HALF * ld * 2;
    const size_t kchunk = (size_t)K * 2;
    const size_t tstep = 2 * hstep;
    const unsigned ldsw = (unsigned)wid * 1024u;
    const int aoff = lds_byte(wr * 64 + fr, fq * 8), boff = lds_byte(wc * 32 + fr, fq * 8);
#define PG8_SA(b, h) (((b) * 2 + (h)) * HTB)
#define PG8_SB(b, h) ((4 + (b) * 2 + (h)) * HTB)
#define PG8_STAGE(bufoff, gbase, voff) do { _Pragma("unroll") for (int _i = 0; _i < 2; ++_i) \
        __builtin_amdgcn_global_load_lds((const unsigned*)((const char*)(gbase) + (voff)[_i]), (PG8_LAS unsigned*)(lds + (bufoff) + ldsw + _i * 8192), 16, 0, 0); } while (0)
#define PG8_LDA(dst, b, h) do { _Pragma("unroll") for (int m = 0; m < 4; ++m) _Pragma("unroll") for (int k = 0; k < 2; ++k) dst[m][k] = *(const PG8_LAS bf16x8*)(lds + PG8_SA(b, h) + aoff + m * 2048 + k * 1024); } while (0)
#define PG8_LDB(dst, b, h) do { _Pragma("unroll") for (int n = 0; n < 2; ++n) _Pragma("unroll") for (int k = 0; k < 2; ++k) dst[n][k] = *(const PG8_LAS bf16x8*)(lds + PG8_SB(b, h) + boff + n * 2048 + k * 1024); } while (0)
#define PG8_MMA(ai, bj, At, Bt) do { __builtin_amdgcn_s_setprio(1); _Pragma("unroll") for (int m = 0; m < 4; ++m) _Pragma("unroll") for (int n = 0; n < 2; ++n) _Pragma("unroll") for (int k = 0; k < 2; ++k) \
        acc[ai][bj][m][n] = __builtin_amdgcn_mfma_f32_16x16x32_bf16(Bt[n][k], At[m][k], acc[ai][bj][m][n], 0, 0, 0); __builtin_amdgcn_s_setprio(0); } while (0)
#define PG8_WAIT_V(n) asm volatile("s_waitcnt vmcnt(" #n ")" ::: "memory")
#define PG8_WAIT_L(n) asm volatile("s_waitcnt lgkmcnt(" #n ")" ::: "memory")
#define PG8_BAR __builtin_amdgcn_s_barrier()
#define PG8_SCHED __builtin_amdgcn_sched_barrier(0)
    Unit cur, nxt; int ui = 0;
    if (!S.next(0, cur)) return;
    f32x4 acc[2][2][4][2];
#pragma unroll
    for (int a = 0; a < 2; ++a)
#pragma unroll
        for (int b = 0; b < 2; ++b)
#pragma unroll
            for (int m = 0; m < 4; ++m)
#pragma unroll
                for (int n = 0; n < 2; ++n) acc[a][b][m][n] = (f32x4){0.f, 0.f, 0.f, 0.f};
    bf16x8 At[4][2], B0[2][2], B1[2][2];
    const char* cA = (const char*)g.A + (size_t)cur.pm * tstep + (size_t)cur.pk * kchunk; const char* cB = (const char*)g.Bt + (size_t)cur.pn * tstep + (size_t)cur.pk * kchunk;
    S.a_ready(cur);
    if constexpr (SP2) {
        PG8_STAGE(PG8_SB(0, 0), cB, voffB); PG8_STAGE(PG8_SB(0, 1), cB + hstep, voffB); PG8_STAGE(PG8_SA(0, 0), cA, voffA); PG8_STAGE(PG8_SA(0, 1), cA + hstep, voffA);
        if (wr == 1) PG8_BAR;
        PG8_WAIT_V(2); PG8_BAR;
        PG8_STAGE(PG8_SB(1, 0), cB + kstep, voffB); PG8_STAGE(PG8_SA(1, 0), cA + kstep, voffA); PG8_STAGE(PG8_SB(1, 1), cB + hstep + kstep, voffB);
        PG8_WAIT_V(6); PG8_BAR;
    } else {
        PG8_STAGE(PG8_SB(0, 0), cB, voffB); PG8_STAGE(PG8_SA(0, 0), cA, voffA); PG8_STAGE(PG8_SB(0, 1), cB + hstep, voffB); PG8_STAGE(PG8_SA(0, 1), cA + hstep, voffA);
        if (wr == 1) PG8_BAR;
        PG8_WAIT_V(4); PG8_BAR;
        PG8_STAGE(PG8_SB(1, 0), cB + kstep, voffB); PG8_STAGE(PG8_SA(1, 0), cA + kstep, voffA); PG8_STAGE(PG8_SB(1, 1), cB + hstep + kstep, voffB);
        PG8_WAIT_V(6); PG8_BAR;
    }
    for (;;) {
        const bool has_next = S.next(ui + 1, nxt);
        const char* nA = has_next ? (const char*)g.A + (size_t)nxt.pm * tstep + (size_t)nxt.pk * kchunk : cA; const char* nB = has_next ? (const char*)g.Bt + (size_t)nxt.pn * tstep + (size_t)nxt.pk * kchunk : cB;
        for (int t = 0; t < nt; t += 2) {
            const bool last = (t == nt - 2);
            const char* a1 = cA + (size_t)(t + 1) * kstep;
            const char* a2 = last ? nA : cA + (size_t)(t + 2) * kstep; const char* b2 = last ? nB : cB + (size_t)(t + 2) * kstep;
            const char* a3 = a2 + kstep; const char* b3 = b2 + kstep;
            if (last && has_next) S.a_ready(nxt);
            if constexpr (SP2) {
            PG8_LDB(B0, 0, 0); PG8_LDB(B1, 0, 1); PG8_SCHED; PG8_LDA(At, 0, 0); PG8_STAGE(PG8_SA(1, 1), a1 + hstep, voffA);
            PG8_WAIT_V(8); PG8_WAIT_L(0); PG8_BAR; PG8_MMA(0, 0, At, B0); PG8_MMA(0, 1, At, B1); PG8_BAR; PG8_SCHED;
            PG8_LDA(At, 0, 1); PG8_STAGE(PG8_SB(0, 0), b2, voffB); PG8_STAGE(PG8_SB(0, 1), b2 + hstep, voffB); PG8_STAGE(PG8_SA(0, 0), a2, voffA);
            PG8_WAIT_V(8); PG8_WAIT_L(0); PG8_BAR; PG8_MMA(1, 0, At, B0); PG8_MMA(1, 1, At, B1); PG8_BAR; PG8_SCHED;
            PG8_LDB(B0, 1, 0); PG8_LDB(B1, 1, 1); PG8_SCHED; PG8_LDA(At, 1, 0); PG8_STAGE(PG8_SA(0, 1), a2 + hstep, voffA);
            PG8_WAIT_V(8); PG8_WAIT_L(0); PG8_BAR; PG8_MMA(0, 0, At, B0); PG8_MMA(0, 1, At, B1); PG8_BAR; PG8_SCHED;
            PG8_LDA(At, 1, 1); PG8_STAGE(PG8_SB(1, 0), b3, voffB); PG8_STAGE(PG8_SB(1, 1), b3 + hstep, voffB); PG8_STAGE(PG8_SA(1, 0), a3, voffA);
            PG8_WAIT_V(8); PG8_WAIT_L(0); PG8_BAR; PG8_MMA(1, 0, At, B0); PG8_MMA(1, 1, At, B1); PG8_BAR; PG8_SCHED;
            } else {
            PG8_LDB(B0, 0, 0); PG8_SCHED; PG8_LDA(At, 0, 0); PG8_STAGE(PG8_SA(1, 1), a1 + hstep, voffA);
            PG8_WAIT_L(8); PG8_BAR; PG8_WAIT_L(0); PG8_MMA(0, 0, At, B0); PG8_BAR; PG8_SCHED;
            PG8_LDB(B1, 0, 1); PG8_STAGE(PG8_SB(0, 0), b2, voffB);
            PG8_BAR; PG8_WAIT_L(0); PG8_MMA(0, 1, At, B1); PG8_BAR;
            PG8_LDA(At, 0, 1); PG8_STAGE(PG8_SA(0, 0), a2, voffA);
            PG8_BAR; PG8_WAIT_L(0); PG8_MMA(1, 0, At, B0); PG8_BAR; PG8_SCHED;
            PG8_STAGE(PG8_SB(0, 1), b2 + hstep, voffB);
            PG8_WAIT_V(6); PG8_BAR; PG8_MMA(1, 1, At, B1); PG8_BAR;
            PG8_LDB(B0, 1, 0); PG8_SCHED; PG8_LDA(At, 1, 0); PG8_STAGE(PG8_SA(0, 1), a2 + hstep, voffA);
            PG8_WAIT_L(8); PG8_BAR; PG8_WAIT_L(0); PG8_MMA(0, 0, At, B0); PG8_BAR; PG8_SCHED;
            PG8_LDB(B1, 1, 1); PG8_STAGE(PG8_SB(1, 0), b3, voffB);
            PG8_BAR; PG8_WAIT_L(0); PG8_MMA(0, 1, At, B1); PG8_BAR;
            PG8_LDA(At, 1, 1); PG8_STAGE(PG8_SA(1, 0), a3, voffA);
            PG8_BAR; PG8_WAIT_L(0); PG8_MMA(1, 0, At, B0); PG8_BAR; PG8_SCHED;
            PG8_STAGE(PG8_SB(1, 1), b3 + hstep, voffB);
            PG8_WAIT_V(6); PG8_BAR; PG8_MMA(1, 1, At, B1); PG8_BAR;
            }
        }
        if constexpr (ALIGN_EPI) { if (wr == 0) PG8_BAR; }
        if constexpr (!Epi::AFTER_DRAIN) { E(acc, cur, wr, wc, fr, fq); S.done(cur); }
        if (!has_next) break;
#pragma unroll
        for (int a = 0; a < 2; ++a)
#pragma unroll
            for (int b = 0; b < 2; ++b)
#pragma unroll
                for (int m = 0; m < 4; ++m)
#pragma unroll
                    for (int n = 0; n < 2; ++n) acc[a][b][m][n] = (f32x4){0.f, 0.f, 0.f, 0.f};
        cur = nxt; cA = nA; cB = nB; ++ui;
        if constexpr (ALIGN_EPI) { if (wr == 1) PG8_BAR; }
    }
    PG8_WAIT_V(0);
    if constexpr (!ALIGN_EPI) { if (wr == 0) PG8_BAR; }
    PG8_BAR;
#undef PG8_SA
#undef PG8_SB
#undef PG8_STAGE
#undef PG8_LDA
#undef PG8_LDB
#undef PG8_MMA
#undef PG8_WAIT_V
#undef PG8_WAIT_L
#undef PG8_BAR
#undef PG8_SCHED
}
}

__device__ __forceinline__ void transpose_item(const float* __restrict__ W, int K, int N, bf16_t* WT, int drow0, int k0, int n0, LAS float* scr, int lane) {
#pragma unroll 8
    for (int i = 0; i < 32; ++i) { const int kk = 2 * i + (lane >> 5); scr[kk * 33 + (lane & 31)] = __builtin_nontemporal_load(W + (size_t)(k0 + kk) * N + n0 + (lane & 31)); }
    asm volatile("s_waitcnt lgkmcnt(0)" ::: "memory");
    const int c = lane & 7;
#pragma unroll
    for (int j = 0; j < 4; ++j) { const int n = (lane >> 3) + 8 * j; const LAS float* s = scr + (8 * c) * 33 + n;
        u32x4 o; o.x = pk2(s[0 * 33], s[1 * 33]); o.y = pk2(s[2 * 33], s[3 * 33]); o.z = pk2(s[4 * 33], s[5 * 33]); o.w = pk2(s[6 * 33], s[7 * 33]);
        *(u32x4*)(WT + (size_t)(drow0 + n) * K + k0 + 8 * c) = o; }
    asm volatile("s_waitcnt lgkmcnt(0)" ::: "memory");
}
template <bool FFN_IN>
__device__ __forceinline__ void transpose_mat(const float* W, int K, int N, bf16_t* WT, int item, LAS float* scr, int lane) {
    const int nblk = N / 32, kb = item / nblk, nb = item % nblk, n0 = nb * 32;
    int drow0 = n0;
    if (FFN_IN) { const int hf = n0 >= FFH ? 1 : 0; const int j = n0 - hf * FFH; drow0 = 256 * (j >> 7) + 128 * hf + (j & 127); }
    transpose_item(W, K, N, WT, drow0, kb * 64, n0, scr, lane);
}

#define MFMA32(a, b, c) __builtin_amdgcn_mfma_f32_32x32x16_bf16((a), (b), (c), 0, 0, 0)
typedef short s16x4 __attribute__((ext_vector_type(4)));
constexpr float LAZY_THR = 8.0f;

template <int EB, bool MASKED, int VSTR>
__device__ __forceinline__ void flash_tile(const LAS unsigned char* kb, const int kstr, const LAS unsigned char* vb, const bf16x8 (&qf)[4], f32x16 (&O)[EB], f32x16& negm,
                                           float& m, float& lsum, float& pmx, const int l32, const int half, const int qpos, const int kpos0) {
    if (__any(pmx > 4096.0f)) {
        const float delta = fmaxf(__builtin_amdgcn_logf(pmx) - 6.0f, 0.0f);
        const float alpha = fexp2(-delta);
        m += delta; lsum *= alpha;
#pragma unroll
        for (int i = 0; i < 16; ++i) negm[i] = -m;
#pragma unroll
        for (int eb = 0; eb < EB; ++eb) O[eb] = O[eb] * alpha;
    }
    f32x16 s0 = negm, s1 = negm;
    {
        bf16x8 ka[8];
        const LAS unsigned char* kp = kb + l32 * kstr + half * 16;
#pragma unroll
        for (int ks = 0; ks < 4; ++ks) { ka[ks] = *(const LAS bf16x8*)(kp + ks * 32); ka[4 + ks] = *(const LAS bf16x8*)(kp + 32 * kstr + ks * 32); }
        __builtin_amdgcn_sched_barrier(0);
#pragma unroll
        for (int ks = 0; ks < 4; ++ks) { s0 = MFMA32(ka[ks], qf[ks], s0); s1 = MFMA32(ka[4 + ks], qf[ks], s1); }
    }
    float psa = 0.f, psb = 0.f;
#pragma unroll
    for (int kbk = 0; kbk < 2; ++kbk) {
        f32x16 sv = kbk == 0 ? s0 : s1;
        if (MASKED) {
#pragma unroll
            for (int i = 0; i < 16; ++i) { const int d = qpos - (kpos0 + 32 * kbk + (i & 3) + 8 * (i >> 2) + 4 * half); if (d > 128 || d < -128) sv[i] = NEGB; }
        }
#pragma unroll
        for (int i = 0; i < 16; i += 2) { sv[i] = fexp2(sv[i]); sv[i + 1] = fexp2(sv[i + 1]); psa += sv[i]; psb += sv[i + 1]; }
#pragma unroll
        for (int st = 0; st < 2; ++st) {
            u32x4 p; p.x = pk2(sv[8 * st + 0], sv[8 * st + 1]); p.y = pk2(sv[8 * st + 2], sv[8 * st + 3]); p.z = pk2(sv[8 * st + 4], sv[8 * st + 5]); p.w = pk2(sv[8 * st + 6], sv[8 * st + 7]);
            const bf16x8 pf = __builtin_bit_cast(bf16x8, p);
#pragma unroll
            for (int eb = 0; eb < EB; ++eb) {
                const LAS unsigned char* a = vb + (32 * kbk + 16 * st) * VSTR + 64 * eb;
                const s16x4 lo = __builtin_amdgcn_ds_read_tr16_b64_v4i16((LAS s16x4*)a);
                const s16x4 hi = __builtin_amdgcn_ds_read_tr16_b64_v4i16((LAS s16x4*)(a + 8 * VSTR));
                const bf16x8 vf = __builtin_shufflevector(lo, hi, 0, 1, 2, 3, 4, 5, 6, 7);
                O[eb] = MFMA32(vf, pf, O[eb]);
            }
        }
    }
    const float ps = psa + psb;
    lsum += ps;
    pmx = ps + __shfl_xor(ps, 32);
}

constexpr int DA_KSTR = 272, DA_KB = 64 * DA_KSTR  , DA_VSTR = 320, DA_VT = 64 * DA_VSTR  ;
constexpr int DS_TILE = 16384, DS_STAGE = 2 * DS_TILE;
__device__ __forceinline__ void diff_attn_unit(LAS unsigned char* lds, const bf16_t* __restrict__ P1, bf16_t* __restrict__ MIX, const float* __restrict__ subln_g,
                                               const float lam, const float one_m_li, const int qrow0, const int h, const int krow_lat0, const int nlat, const int krow_ctx0, const int nt,
                                               const int tid, const int wave, const int lane) {
    const int l32 = lane & 31, half = lane >> 5;
    const int sj = wave & 1, qblk = wave >> 1;
    const int qrow = qrow0 + 32 * qblk + l32;
    bf16x8 qf[4];
    { const bf16_t* qp = P1 + (size_t)qrow * EVEN_IN + 1024 + h * 128 + sj * 64 + 8 * half;
#pragma unroll
      for (int ks = 0; ks < 4; ++ks) qf[ks] = *(const bf16x8*)(qp + 16 * ks); }
    f32x16 O[4], negm;
#pragma unroll
    for (int i = 0; i < 16; ++i) negm[i] = 0.f;
#pragma unroll
    for (int eb = 0; eb < 4; ++eb)
#pragma unroll
        for (int i = 0; i < 16; ++i) O[eb][i] = 0.f;
    float m = 0.f, l = 0.f, pmx = 0.f;
    int kof[4], vof[4];
#pragma unroll
    for (int ks = 0; ks < 4; ++ks) kof[ks] = l32 * 256 + (((sj * 8 + ks * 2 + half) ^ (l32 & 15)) << 4);
    { const int g4 = lane >> 4, q4 = (lane & 15) >> 2, p4 = lane & 3;
#pragma unroll
      for (int eb = 0; eb < 4; ++eb) vof[eb] = (4 * (g4 >> 1) + q4) * 256 + 64 * (eb ^ q4) + 32 * (g4 & 1) + 8 * p4; }
    const int srow = tid >> 4;
    const bf16_t* ksrc = P1 + (size_t)srow * EVEN_IN + 1536 + h * 128 + (((tid & 15) ^ (srow & 15)) << 3);
    const bf16_t* vsrc = P1 + (size_t)srow * EVEN_IN + 2048 + h * 128 + (((tid & 15) ^ (4 * (srow & 3))) << 3);
#define DA_ROW(t) (((t) < nlat) ? krow_lat0 + 64 * (t) : krow_ctx0 + 64 * ((t) - nlat))
#define DA_DMA(t, stg) do { const size_t ro_ = (size_t)DA_ROW(t) * EVEN_IN; LAS unsigned char* db_ = lds + (stg) * DS_STAGE + wave * 1024; \
        _Pragma("unroll") for (int i_ = 0; i_ < 2; ++i_) { \
            __builtin_amdgcn_global_load_lds((const unsigned*)(ksrc + ro_ + (size_t)(32 * i_) * EVEN_IN), (LAS unsigned*)(db_ + i_ * 8192), 16, 0, 0); \
            __builtin_amdgcn_global_load_lds((const unsigned*)(vsrc + ro_ + (size_t)(32 * i_) * EVEN_IN), (LAS unsigned*)(db_ + DS_TILE + i_ * 8192), 16, 0, 0); } } while (0)
    DA_DMA(0, 0); DA_DMA(1, 1);
    asm volatile("s_waitcnt vmcnt(4)" ::: "memory");
    __builtin_amdgcn_s_barrier();
    int stg = 0, stg2 = 2;
    for (int t = 0; t < nt; ++t) {
        if (t + 2 < nt) DA_DMA(t + 2, stg2);
        const LAS unsigned char* kb = lds + stg * DS_STAGE;
        const LAS unsigned char* vb = kb + DS_TILE;
        if (__any(pmx > 4096.0f)) {
            const float delta = fmaxf(__builtin_amdgcn_logf(pmx) - 6.0f, 0.0f);
            const float alpha = fexp2(-delta);
            m += delta; l *= alpha;
#pragma unroll
            for (int i = 0; i < 16; ++i) negm[i] = -m;
#pragma unroll
            for (int eb = 0; eb < 4; ++eb) O[eb] = O[eb] * alpha;
        }
        f32x16 s0 = negm, s1 = negm;
        {
            bf16x8 ka[8];
#pragma unroll
            for (int ks = 0; ks < 4; ++ks) { ka[ks] = *(const LAS bf16x8*)(kb + kof[ks]); ka[4 + ks] = *(const LAS bf16x8*)(kb + kof[ks] + 8192); }
            __builtin_amdgcn_sched_barrier(0);
#pragma unroll
            for (int ks = 0; ks < 4; ++ks) { s0 = MFMA32(ka[ks], qf[ks], s0); s1 = MFMA32(ka[4 + ks], qf[ks], s1); }
        }
        float psa = 0.f, psb = 0.f;
#pragma unroll
        for (int kbk = 0; kbk < 2; ++kbk) {
            f32x16 sv = kbk == 0 ? s0 : s1;
#pragma unroll
            for (int i = 0; i < 16; i += 2) { sv[i] = fexp2(sv[i]); sv[i + 1] = fexp2(sv[i + 1]); psa += sv[i]; psb += sv[i + 1]; }
#pragma unroll
            for (int st = 0; st < 2; ++st) {
                u32x4 p; p.x = pk2(sv[8 * st + 0], sv[8 * st + 1]); p.y = pk2(sv[8 * st + 2], sv[8 * st + 3]); p.z = pk2(sv[8 * st + 4], sv[8 * st + 5]); p.w = pk2(sv[8 * st + 6], sv[8 * st + 7]);
                const bf16x8 pf = __builtin_bit_cast(bf16x8, p);
#pragma unroll
                for (int eb = 0; eb < 4; ++eb) {
                    const LAS unsigned char* a = vb + vof[eb] + (32 * kbk + 16 * st) * 256;
                    const s16x4 lo = __builtin_amdgcn_ds_read_tr16_b64_v4i16((LAS s16x4*)a);
                    const s16x4 hi = __builtin_amdgcn_ds_read_tr16_b64_v4i16((LAS s16x4*)(a + 8 * 256));
                    O[eb] = MFMA32(__builtin_shufflevector(lo, hi, 0, 1, 2, 3, 4, 5, 6, 7), pf, O[eb]);
                }
            }
        }
        { const float ps = psa + psb; l += ps; pmx = ps + __shfl_xor(ps, 32); }
        if (t + 2 < nt) asm volatile("s_waitcnt vmcnt(4) lgkmcnt(0)" ::: "memory"); else asm volatile("s_waitcnt vmcnt(0) lgkmcnt(0)" ::: "memory");
        __builtin_amdgcn_s_barrier();
        stg = stg == 2 ? 0 : stg + 1; stg2 = stg2 == 2 ? 0 : stg2 + 1;
    }
#undef DA_ROW
#undef DA_DMA
    l += __shfl_xor(l, 32);
    LAS float* xch = (LAS float*)lds + qblk * 4096 + lane;
    if (sj == 1) {
        const float i1 = lam / l;
#pragma unroll
        for (int eb = 0; eb < 4; ++eb)
#pragma unroll
            for (int i = 0; i < 16; ++i) xch[(eb * 16 + i) * 64] = O[eb][i] * i1;
    }
    __syncthreads();
    if (sj == 0) {
        const float i0 = 1.0f / l;
        float ss = 0.f;
#pragma unroll
        for (int eb = 0; eb < 4; ++eb)
#pragma unroll
            for (int i = 0; i < 16; ++i) { const float o = O[eb][i] * i0 - xch[(eb * 16 + i) * 64]; O[eb][i] = o; ss += o * o; }
        ss += __shfl_xor(ss, 32);
        const float r = one_m_li / sqrtf(ss * (1.0f / 128.0f) + EPS);
        bf16_t* op = MIX + (size_t)qrow * DM + 512 + h * 128 + 4 * half;
#pragma unroll
        for (int eb = 0; eb < 4; ++eb)
#pragma unroll
            for (int gi = 0; gi < 4; ++gi) {
                const int e0 = 32 * eb + 8 * gi;
                const f32x4 g4v = *(const f32x4*)(subln_g + e0 + 4 * half);
                u32x2 w; w.x = pk2(O[eb][4 * gi] * r * g4v[0], O[eb][4 * gi + 1] * r * g4v[1]); w.y = pk2(O[eb][4 * gi + 2] * r * g4v[2], O[eb][4 * gi + 3] * r * g4v[3]);
                *(u32x2*)(op + e0) = w;
            }
    }
    __syncthreads();
}

constexpr int WA_KB = 64 * 144  , WA_VSTR = 192, WA_VB = 64 * WA_VSTR  ;
__device__ __forceinline__ void win_attn_unit(LAS unsigned char* lds, const bf16_t* __restrict__ QKV, bf16_t* __restrict__ MIX, const float* __restrict__ sink,
                                              const int b, const int kvh, const int start, const int tid, const int wave, const int lane) {
    const int l32 = lane & 31, half = lane >> 5;
    LAS unsigned char* KB[2] = {lds, lds + WA_KB};
    LAS unsigned char* VT[2] = {lds + 2 * WA_KB, lds + 2 * WA_KB + WA_VB};
    const int head = kvh * 4 + (wave >> 1);
    const int qpos = start + (wave & 1) * 32 + l32;
    bf16x8 qf[4];
    { const bf16_t* qp = QKV + (size_t)(b * SEQ + qpos) * ODD_IN + head * 64 + 8 * half;
#pragma unroll
      for (int ks = 0; ks < 4; ++ks) qf[ks] = *(const bf16x8*)(qp + 16 * ks); }
    f32x16 O[2], negm;
#pragma unroll
    for (int i = 0; i < 16; ++i) negm[i] = 0.f;
#pragma unroll
    for (int eb = 0; eb < 2; ++eb)
#pragma unroll
        for (int i = 0; i < 16; ++i) O[eb][i] = 0.f;
    float m = 0.f, l = 0.f, pmx = 0.f;
    const int vlane = (4 * (lane >> 5) + ((lane & 15) >> 2)) * WA_VSTR + 32 * ((lane >> 4) & 1) + 8 * (lane & 3);
    const int t_lo = start >= 128 ? 0 : (128 - start) >> 6;
    const int t_hi = min(5, (SEQ + 128 - start) >> 6);
    const int nbd = t_hi - t_lo, nt = nbd + 4;
    const int skey = tid >> 3, sch = tid & 7;
    u32x4 k0, v0, k1, v1;
#define WA_LOAD(n, KR, VR) do { const int kr_ = ((n) < nbd) ? b * SEQ + start - 128 + 64 * (t_lo + (n)) : NLAT + b * CTXL + 64 * ((n) - nbd); \
        const bf16_t* rp_ = QKV + (size_t)(kr_ + skey) * ODD_IN + kvh * 64 + sch * 8; KR = *(const u32x4*)(rp_ + 1024); VR = *(const u32x4*)(rp_ + 1280); } while (0)
#define WA_STORE(buf, KR, VR) do { *(LAS u32x4*)(KB[buf] + skey * 144 + sch * 16) = KR; *(LAS u32x4*)(VT[buf] + skey * WA_VSTR + sch * 16) = VR; } while (0)
#define WA_TILE(n, buf) do { if ((n) < nbd) flash_tile<2, true, WA_VSTR>(KB[buf], 144, VT[buf] + vlane, qf, O, negm, m, l, pmx, l32, half, qpos, start - 128 + 64 * (t_lo + (n))); \
        else flash_tile<2, false, WA_VSTR>(KB[buf], 144, VT[buf] + vlane, qf, O, negm, m, l, pmx, l32, half, 0, 0); } while (0)
    WA_LOAD(0, k0, v0); WA_LOAD(1, k1, v1);
    WA_STORE(0, k0, v0);
    __syncthreads();
    for (int n = 0; n < nt; n += 2) {
        if (n + 2 < nt) WA_LOAD(n + 2, k0, v0);
        WA_TILE(n, 0);
        if (n + 1 < nt) WA_STORE(1, k1, v1);
        __syncthreads();
        if (n + 1 >= nt) break;
        if (n + 3 < nt) WA_LOAD(n + 3, k1, v1);
        WA_TILE(n + 1, 1);
        if (n + 2 < nt) WA_STORE(0, k0, v0);
        __syncthreads();
    }
#undef WA_LOAD
#undef WA_STORE
#undef WA_TILE
    const float sk2 = sink[head] * LOG2E;
    l += __shfl_xor(l, 32);
    float sc;
    { const float mn = fmaxf(m, sk2), al = fexp2(m - mn); sc = al / (l * al + fexp2(sk2 - mn)); }
    bf16_t* op = MIX + (size_t)(b * SEQ + qpos) * DM + head * 64 + 4 * half;
#pragma unroll
    for (int eb = 0; eb < 2; ++eb)
#pragma unroll
        for (int gi = 0; gi < 4; ++gi) {
            const int e0 = 32 * eb + 8 * gi;
            u32x2 w; w.x = pk2(O[eb][4 * gi] * sc, O[eb][4 * gi + 1] * sc); w.y = pk2(O[eb][4 * gi + 2] * sc, O[eb][4 * gi + 3] * sc);
            *(u32x2*)(op + e0) = w;
        }
}

constexpr int CM_VS = 320;
__device__ __forceinline__ void chunk_mlp_units(LAS unsigned char* lds, const bf16_t* __restrict__ P1, const bf16_t* __restrict__ Wsg, const float* __restrict__ sgu_b,
                                                bf16_t* __restrict__ MIX, const int u_first, const int u_step, const int u_end, const int tid, const int wave, const int lane) {
    const int l32 = lane & 31, half = lane >> 5;
    const int pb = wave >> 1, cb0 = (wave & 1) * 2;
    const LAS unsigned char* tb = lds + (8 * half + ((lane & 15) >> 2)) * CM_VS + 32 * ((lane >> 4) & 1) + 8 * (lane & 3) + 64 * cb0;
    u32x4 raw[4];
#define CM_LOADV(u_) do { const int rb_ = (u_) >> 2, g_ = (u_) & 3; _Pragma("unroll") for (int pass = 0; pass < 4; ++pass) \
        raw[pass] = *(const u32x4*)(P1 + (size_t)(rb_ * 128 + pass * 32 + (tid >> 4)) * EVEN_IN + 512 + g_ * 128 + (tid & 15) * 8); } while (0)
    if (u_first < u_end) CM_LOADV(u_first);
    for (int u = u_first; u < u_end; u += u_step) {
        const int rb = u >> 2, g = u & 3, rowbase = rb * 128;
#pragma unroll
        for (int pass = 0; pass < 4; ++pass) {
            const int q = pass * 32 + (tid >> 4), ch = tid & 15;
            float x[8];
#pragma unroll
            for (int k = 0; k < 4; ++k) { x[2 * k] = bf_lo(raw[pass][k]); x[2 * k + 1] = bf_hi(raw[pass][k]); }
            float s = 0.f;
#pragma unroll
            for (int k = 0; k < 8; ++k) s += x[k];
            s += __shfl_xor(s, 1); s += __shfl_xor(s, 2); s += __shfl_xor(s, 4); s += __shfl_xor(s, 8);
            const float mu = s * (1.0f / 128.0f);
            float v = 0.f;
#pragma unroll
            for (int k = 0; k < 8; ++k) { x[k] -= mu; v += x[k] * x[k]; }
            v += __shfl_xor(v, 1); v += __shfl_xor(v, 2); v += __shfl_xor(v, 4); v += __shfl_xor(v, 8);
            const float rstd = 1.0f / sqrtf(v * (1.0f / 128.0f) + EPS);
            u32x4 w; w.x = pk2(x[0] * rstd, x[1] * rstd); w.y = pk2(x[2] * rstd, x[3] * rstd); w.z = pk2(x[4] * rstd, x[5] * rstd); w.w = pk2(x[6] * rstd, x[7] * rstd);
            *(LAS u32x4*)(lds + q * CM_VS + ch * 16) = w;
        }
        const int p = 32 * pb + l32;
        const size_t row = (size_t)(rowbase + p);
        const bf16_t* up = P1 + row * EVEN_IN + g * 128 + 32 * cb0 + 4 * half;
        u32x2 uv0[4], uv1[4];
#pragma unroll
        for (int gi = 0; gi < 4; ++gi) { uv0[gi] = *(const u32x2*)(up + 8 * gi); uv1[gi] = *(const u32x2*)(up + 32 + 8 * gi); }
        const float bias = sgu_b[g * 128 + p];
        if (u + u_step < u_end) CM_LOADV(u + u_step);
        __syncthreads();
        f32x16 a0, a1;
#pragma unroll
        for (int i = 0; i < 16; ++i) { a0[i] = 0.f; a1[i] = 0.f; }
        const bf16_t* wp = Wsg + (size_t)(g * 128 + 32 * pb + l32) * 128 + 8 * half;
#pragma unroll
        for (int ks = 0; ks < 8; ++ks) {
            const bf16x8 bw = *(const bf16x8*)(wp + 16 * ks);
            const LAS unsigned char* t0 = tb + 16 * ks * CM_VS;
            const s16x4 lo0 = __builtin_amdgcn_ds_read_tr16_b64_v4i16((LAS s16x4*)t0), hi0 = __builtin_amdgcn_ds_read_tr16_b64_v4i16((LAS s16x4*)(t0 + 4 * CM_VS));
            const s16x4 lo1 = __builtin_amdgcn_ds_read_tr16_b64_v4i16((LAS s16x4*)(t0 + 64)), hi1 = __builtin_amdgcn_ds_read_tr16_b64_v4i16((LAS s16x4*)(t0 + 64 + 4 * CM_VS));
            a0 = MFMA32(__builtin_shufflevector(lo0, hi0, 0, 1, 2, 3, 4, 5, 6, 7), bw, a0);
            a1 = MFMA32(__builtin_shufflevector(lo1, hi1, 0, 1, 2, 3, 4, 5, 6, 7), bw, a1);
        }
        bf16_t* op = MIX + row * DM + g * 128 + 32 * cb0 + 4 * half;
#pragma unroll
        for (int gi = 0; gi < 4; ++gi) {
            const u32x2 u0 = uv0[gi], u1 = uv1[gi];
            u32x2 w0, w1;
            w0.x = pk2(bf_lo(u0.x) * (a0[4 * gi] + bias), bf_hi(u0.x) * (a0[4 * gi + 1] + bias)); w0.y = pk2(bf_lo(u0.y) * (a0[4 * gi + 2] + bias), bf_hi(u0.y) * (a0[4 * gi + 3] + bias));
            w1.x = pk2(bf_lo(u1.x) * (a1[4 * gi] + bias), bf_hi(u1.x) * (a1[4 * gi + 1] + bias)); w1.y = pk2(bf_lo(u1.y) * (a1[4 * gi + 2] + bias), bf_hi(u1.y) * (a1[4 * gi + 3] + bias));
            *(u32x2*)(op + 8 * gi) = w0; *(u32x2*)(op + 32 + 8 * gi) = w1;
        }
        __syncthreads();
    }
#undef CM_LOADV
}

template <bool IN_BF16>
__device__ __forceinline__ void load_row16(const void* src, int lane, f32x4 (&v)[4]) {
    if (IN_BF16) {
        const bf16_t* p = (const bf16_t*)src;
#pragma unroll
        for (int hh = 0; hh < 2; ++hh) { const u32x4 raw = *(const u32x4*)(p + hh * 512 + 8 * lane);
            v[2 * hh] = (f32x4){bf_lo(raw.x), bf_hi(raw.x), bf_lo(raw.y), bf_hi(raw.y)}; v[2 * hh + 1] = (f32x4){bf_lo(raw.z), bf_hi(raw.z), bf_lo(raw.w), bf_hi(raw.w)}; }
    } else {
        const float* p = (const float*)src;
#pragma unroll
        for (int hh = 0; hh < 2; ++hh) { v[2 * hh] = __builtin_nontemporal_load((const f32x4*)(p + hh * 512 + 8 * lane)); v[2 * hh + 1] = __builtin_nontemporal_load((const f32x4*)(p + hh * 512 + 8 * lane + 4)); }
    }
}
template <bool IN_BF16>
__device__ __forceinline__ void norm_rows(const void* __restrict__ lat, const void* __restrict__ ctxp, const float* __restrict__ g, const float* __restrict__ modl,
                                          const int sh_off, const int sc_off, bf16_t* __restrict__ dst, const int nrows, const int gw, const int ngw, const int lane) {
    constexpr int ES = IN_BF16 ? 2 : 4;
    for (int row = gw; row < nrows; row += ngw) {
        const bool isl = row < NLAT;
        const unsigned char* src = isl ? (const unsigned char*)lat + (size_t)row * DM * ES : (const unsigned char*)ctxp + (size_t)(row - NLAT) * DM * ES;
        const float* mrow = modl + (isl ? (row >> 12) : 8) * 6144;
        f32x4 v[4]; load_row16<IN_BF16>(src, lane, v);
        float ss = 0.f;
#pragma unroll
        for (int j = 0; j < 4; ++j) ss += (v[j][0] * v[j][0] + v[j][1] * v[j][1]) + (v[j][2] * v[j][2] + v[j][3] * v[j][3]);
        const float rstd = 1.0f / sqrtf(wave_sum(ss) * (1.0f / DM) + EPS);
#pragma unroll
        for (int hh = 0; hh < 2; ++hh) {
            const int col = hh * 512 + 8 * lane;
            u32x4 w;
#pragma unroll
            for (int q = 0; q < 2; ++q) {
                const f32x4 gg = *(const f32x4*)(g + col + 4 * q), sc = *(const f32x4*)(mrow + sc_off + col + 4 * q), sh = *(const f32x4*)(mrow + sh_off + col + 4 * q);
                const f32x4 o = v[2 * hh + q] * rstd * gg * (sc + 1.0f) + sh;
                if (q == 0) { w.x = pk2(o[0], o[1]); w.y = pk2(o[2], o[3]); } else { w.z = pk2(o[0], o[1]); w.w = pk2(o[2], o[3]); }
            }
            *(u32x4*)(dst + (size_t)row * DM + col) = w;
        }
    }
}

#define XB_TMO      128
#define XB_XCNT(j)  (256  + 64 * (j))
#define XB_XSUB(j)  (1280 + 64 * (j))
#define XB_XGEN(j)  (2304 + 64 * (j))
#define XB_TOP      3328
#define XB_TOPGEN   3392
#define XCD_BAR_WORDS 3456
#define XB_SPIN_CAP (1u << 18)
__device__ __forceinline__ unsigned xb_ld(unsigned* p)              { return __hip_atomic_load(p, __ATOMIC_RELAXED, __HIP_MEMORY_SCOPE_AGENT); }
__device__ __forceinline__ unsigned xb_add(unsigned* p, unsigned v) { return __hip_atomic_fetch_add(p, v, __ATOMIC_RELAXED, __HIP_MEMORY_SCOPE_AGENT); }
__device__ __forceinline__ unsigned xb_xcc_id() { return (unsigned)__builtin_amdgcn_s_getreg((3 << 11) | 20) & 0xFu; }
#define XB_SPIN(cond, bar) do { unsigned _sp = 0; while (cond) { __builtin_amdgcn_s_sleep(1); \
    if ((++_sp & 255u) == 0u) { if (xb_ld(&(bar)[XB_TMO])) break; if (_sp > XB_SPIN_CAP) { atomicAdd(&(bar)[XB_TMO], 1u); break; } } } } while (0)
struct XcdBarrier { unsigned* bar; unsigned x; volatile LAS unsigned* st; };
__device__ __forceinline__ XcdBarrier xcd_barrier_post(unsigned* bar, volatile LAS unsigned* st) {
    XcdBarrier b; b.bar = bar; b.x = xb_xcc_id(); b.st = st;
    if (threadIdx.x == 0) (void)xb_add(&bar[XB_XCNT(b.x)], 1u);
    return b;
}
__device__ __forceinline__ void xcd_barrier_complete(unsigned* bar, unsigned x, unsigned& nloc, unsigned& nx) {
    const unsigned G = gridDim.x * gridDim.y * gridDim.z;
    unsigned sum, cnt, mine, sp = 0u;
    for (;;) {
        sum = 0u; cnt = 0u; mine = 0u;
#pragma unroll
        for (unsigned j = 0; j < 16; ++j) { const unsigned c = xb_ld(&bar[XB_XCNT(j)]); sum += c; cnt += (c > 0u) ? 1u : 0u; mine = (j == x) ? c : mine; }
        if (sum == G) break;
        __builtin_amdgcn_s_sleep(1);
        if ((++sp & 255u) == 0u) { if (xb_ld(&bar[XB_TMO])) break; if (sp > XB_SPIN_CAP) { atomicAdd(&bar[XB_TMO], 1u); break; } }
    }
    nloc = mine > 0u ? mine : 1u; nx = cnt > 0u ? cnt : 1u;
}
__device__ __forceinline__ void xcd_barrier(const XcdBarrier& b) {
    asm volatile("s_waitcnt vmcnt(0)" ::: "memory");
    __syncthreads();
    if (threadIdx.x == 0) {
        unsigned* bar = b.bar;
        __builtin_amdgcn_s_waitcnt(0);
        unsigned nloc = b.st[0], nx = b.st[1];
        if (nloc == 0u) { xcd_barrier_complete(bar, b.x, nloc, nx); b.st[0] = nloc; b.st[1] = nx; }
        const unsigned old = xb_add(&bar[XB_XSUB(b.x)], 1u);
        const unsigned gen = old / nloc;
        if (old + 1u == (gen + 1u) * nloc) {
            __builtin_amdgcn_fence(__ATOMIC_RELEASE, "agent");
            asm volatile("s_waitcnt vmcnt(0)" ::: "memory");
            const unsigned og = xb_add(&bar[XB_TOP], 1u);
            const unsigned tg = og / nx;
            if (og + 1u == (tg + 1u) * nx) xb_add(&bar[XB_TOPGEN], 1u);
            else XB_SPIN(xb_ld(&bar[XB_TOPGEN]) == tg, bar);
            __builtin_amdgcn_fence(__ATOMIC_ACQUIRE, "agent");
            xb_add(&bar[XB_XGEN(b.x)], 1u);
            asm volatile("s_waitcnt vmcnt(0)" ::: "memory");
        } else {
            XB_SPIN(xb_ld(&bar[XB_XGEN(b.x)]) == gen, bar);
            __builtin_amdgcn_fence(__ATOMIC_ACQUIRE, "agent");
            asm volatile("s_waitcnt vmcnt(0)" ::: "memory");
        }
    }
    __syncthreads();
}

struct Params { const float* in[23]; float* out; unsigned char* ws; int ph_lo, ph_hi; };
enum { I_X = 0, I_C, I_CTX, I_CCTX, I_ADA_W, I_ADA_B, I_N1G, I_N2G, I_FFN_IN, I_FFN_OUT, I_EV_IN, I_EV_OUT, I_SGU_W, I_SGU_B, I_LQ1, I_LK1, I_LQ2, I_LK2, I_SUBLN, I_OD_QKV, I_OD_OUT, I_SINK, I_FINAL_G };
constexpr int NPHASE = 16;
#define DUP_MLP 0
#define EXTRA_SYNCS 0
#define DUP_MASK 0u
#define PROBE 0
#ifdef ONLY_PH
#define PH_ON(k) ((ONLY_PH) == (k))
#else
#define PH_ON(k) true
#endif

__global__ void __launch_bounds__(512, 2) mega_fwd(Params P) {
    extern __shared__ __attribute__((aligned(16))) unsigned char lds_raw[];
    LAS unsigned char* lds = (LAS unsigned char*)lds_raw;
    cg::grid_group grid = cg::this_grid();
    { volatile LAS unsigned* st0 = (volatile LAS unsigned*)(lds + 131072); if (threadIdx.x < 4) st0[threadIdx.x] = 0u; }
    __syncthreads();
    const XcdBarrier xbar = xcd_barrier_post((unsigned*)(P.ws + WS_BAR), (volatile LAS unsigned*)(lds + 131072));
    const int bid = blockIdx.x;
    unsigned char* ws = P.ws;
    bf16_t* WE_IN = (bf16_t*)(ws + WS_WE_IN); bf16_t* WE_OUT = (bf16_t*)(ws + WS_WE_OUT); bf16_t* WF_IN = (bf16_t*)(ws + WS_WF_IN); bf16_t* WF_OUT = (bf16_t*)(ws + WS_WF_OUT);
    bf16_t* WO_QKV = (bf16_t*)(ws + WS_WO_QKV); bf16_t* WO_OUT = (bf16_t*)(ws + WS_WO_OUT); bf16_t* SGU = (bf16_t*)(ws + WS_SGU);
    float* MOD = (float*)(ws + WS_MOD); float* ROPE = (float*)(ws + WS_ROPE); float* HC = (float*)(ws + WS_HC);
    bf16_t* ABUF = (bf16_t*)(ws + WS_A); bf16_t* MIX = (bf16_t*)(ws + WS_MIX); bf16_t* BIG = (bf16_t*)(ws + WS_BIG); bf16_t* HB = (bf16_t*)(ws + WS_HB); float* PART = (float*)(ws + WS_PART);
    const float* X = P.in[I_X]; const float* CTX = P.in[I_CTX]; float* OUT = P.out;

#if PROBE
    unsigned long long t_prev = __builtin_amdgcn_s_memrealtime(), cA = 0, cB = 0, cC = 0, cD = 0;
#endif
    for (int pi = 2 * P.ph_lo; pi < 2 * P.ph_hi; ++pi) {
        const int ph = pi >> 1;
        if ((pi & 1) && !((DUP_MASK >> ph) & 1u)) continue;
        int G = gridDim.x; asm volatile("" : "+s"(G));
        int tid = threadIdx.x; asm volatile("" : "+v"(tid));
        const int lane = tid & 63, wave = __builtin_amdgcn_readfirstlane(tid >> 6);
        const int gw = bid * 8 + wave, ngw = G * 8;
        if (ph == 0 && PH_ON(0)) {
            LAS float* scr = (LAS float*)lds; LAS float* red = (LAS float*)(lds + 9 * 1024 * 4);
            for (int it = bid; it < 192; it += G) {
                const int l = it / 96, n0 = (it % 96) * 64;
                for (int idx = tid; idx < 9216; idx += 512) { const int r = idx >> 10, k = idx & 1023; const float cv = r < 8 ? P.in[I_C][r * 1024 + k] : P.in[I_CCTX][k];
                    scr[idx] = cv / (1.0f + __expf(-cv)); }
                __syncthreads();
                float acc[9];
#pragma unroll
                for (int r = 0; r < 9; ++r) acc[r] = 0.f;
                const float* Wp = P.in[I_ADA_W] + (size_t)l * 1024 * 6144 + (size_t)(wave * 128) * 6144 + n0 + lane;
#pragma unroll 4
                for (int kk = 0; kk < 128; ++kk) { const float wv = __builtin_nontemporal_load(Wp + (size_t)kk * 6144);
#pragma unroll
                    for (int r = 0; r < 9; ++r) acc[r] += scr[r * 1024 + wave * 128 + kk] * wv; }
#pragma unroll
                for (int r = 0; r < 9; ++r) red[(wave * 9 + r) * 64 + lane] = acc[r];
                __syncthreads();
                for (int idx = tid; idx < 576; idx += 512) { const int r = idx >> 6, cc = idx & 63; float s = 0.f;
#pragma unroll
                    for (int w = 0; w < 8; ++w) s += red[(w * 9 + r) * 64 + cc];
                    MOD[(size_t)(l * 9 + r) * 6144 + n0 + cc] = s + P.in[I_ADA_B][l * 6144 + n0 + cc]; }
                __syncthreads();
            }
            for (int idx = bid * 512 + tid; idx < 1024; idx += G * 512) { const int pos = idx >> 4, i = idx & 15;
                const float inv = fexp2(-(float)i * (13.287712379549449f / 16.0f)); const float rev = (float)pos * inv * 0.15915494309189535f;
                ROPE[idx] = __builtin_amdgcn_cosf(rev); ROPE[1024 + idx] = __builtin_amdgcn_sinf(rev); }
            for (int idx = bid * 512 + tid; idx < 4 * 128 * 128 / 2; idx += G * 512) { const f32x2 v = *(const f32x2*)(P.in[I_SGU_W] + 2 * idx); ((unsigned*)SGU)[idx] = pk2(v.x, v.y); }
            LAS float* tscr = (LAS float*)(lds + wave * 8448);
            constexpr int T0 = 16 * 80, T1 = 16 * 32, T2 = 16 * 176, T3 = 44 * 32, T4 = 16 * 48, T5 = 16 * 32;
            constexpr int NIT = T0 + T1 + 2 * T2 + 2 * T3 + T4 + T5;
            for (int it = gw; it < NIT; it += ngw) {
                int r = it;
                if (r < T0) { transpose_mat<false>(P.in[I_EV_IN], DM, EVEN_IN, WE_IN, r, tscr, lane); continue; } r -= T0;
                if (r < T1) { transpose_mat<false>(P.in[I_EV_OUT], DM, DM, WE_OUT, r, tscr, lane); continue; } r -= T1;
                if (r < T2) { transpose_mat<true>(P.in[I_FFN_IN], DM, 2 * FFH, WF_IN, r, tscr, lane); continue; } r -= T2;
                if (r < T2) { transpose_mat<true>(P.in[I_FFN_IN] + (size_t)DM * 2 * FFH, DM, 2 * FFH, WF_IN + (size_t)2 * FFH * DM, r, tscr, lane); continue; } r -= T2;
                if (r < T3) { transpose_mat<false>(P.in[I_FFN_OUT], FFH, DM, WF_OUT, r, tscr, lane); continue; } r -= T3;
                if (r < T3) { transpose_mat<false>(P.in[I_FFN_OUT] + (size_t)FFH * DM, FFH, DM, WF_OUT + (size_t)DM * FFH, r, tscr, lane); continue; } r -= T3;
                if (r < T4) { transpose_mat<false>(P.in[I_OD_QKV], DM, ODD_IN, WO_QKV, r, tscr, lane); continue; } r -= T4;
                transpose_mat<false>(P.in[I_OD_OUT], DM, DM, WO_OUT, r, tscr, lane);
            }
        } else if ((ph == 1 || ph == 5 || ph == 8 || ph == 12) && PH_ON(1)) {
            const int l = ph >= 8 ? 1 : 0; const bool first = (ph == 1 || ph == 8);
            const float* ng = P.in[first ? I_N1G : I_N2G] + l * DM; const float* md = MOD + (size_t)l * 9 * 6144;
            if (ph == 1) norm_rows<false>(X, CTX, ng, md, 0, 1024, ABUF, MROWS, gw, ngw, lane);
            else {
                norm_rows<true>(HB, HB + (size_t)NLAT * DM, ng, md, first ? 0 : 3072, first ? 1024 : 4096, ABUF, NLAT, gw, ngw, lane);
                if (ph != 12) {
                    const int npart = ph == 5 ? 4 : 2; const float* fg = MOD + (size_t)8 * 6144 + (ph == 5 ? 2048 : 5120);
                    const float* mrow = md + 8 * 6144; const int sh_off = first ? 0 : 3072, sc_off = first ? 1024 : 4096;
                    for (int r = gw; r < NCTX; r += ngw) {
                        f32x4 v[4];
                        if (ph == 5) load_row16<false>(CTX + (size_t)r * DM, lane, v); else load_row16<true>(HB + (size_t)(NLAT + r) * DM, lane, v);
                        f32x4 a[4];
#pragma unroll
                        for (int j = 0; j < 4; ++j) a[j] = (f32x4){0.f, 0.f, 0.f, 0.f};
                        for (int k = 0; k < npart; ++k) { f32x4 p[4]; load_row16<false>(PART + ((size_t)k * NCTX + r) * DM, lane, p);
#pragma unroll
                            for (int j = 0; j < 4; ++j) a[j] += p[j]; }
                        f32x4 gg[4]; load_row16<false>(fg, lane, gg);
                        float ss = 0.f; u32x4 hw[2];
#pragma unroll
                        for (int j = 0; j < 4; ++j) { const f32x4 h = v[j] + gg[j] * a[j]; const unsigned w0 = pk2(h[0], h[1]), w1 = pk2(h[2], h[3]);
                            if (j & 1) { hw[j >> 1].z = w0; hw[j >> 1].w = w1; } else { hw[j >> 1].x = w0; hw[j >> 1].y = w1; }
                            v[j] = (f32x4){bf_lo(w0), bf_hi(w0), bf_lo(w1), bf_hi(w1)};
                            ss += (v[j][0] * v[j][0] + v[j][1] * v[j][1]) + (v[j][2] * v[j][2] + v[j][3] * v[j][3]); }
                        *(u32x4*)(HB + (size_t)(NLAT + r) * DM + 8 * lane) = hw[0]; *(u32x4*)(HB + (size_t)(NLAT + r) * DM + 512 + 8 * lane) = hw[1];
                        const float rstd = 1.0f / sqrtf(wave_sum(ss) * (1.0f / DM) + EPS);
#pragma unroll
                        for (int hh = 0; hh < 2; ++hh) {
                            const int col = hh * 512 + 8 * lane; u32x4 w;
#pragma unroll
                            for (int q = 0; q < 2; ++q) {
                                const f32x4 g4 = *(const f32x4*)(ng + col + 4 * q), sc = *(const f32x4*)(mrow + sc_off + col + 4 * q), sh = *(const f32x4*)(mrow + sh_off + col + 4 * q);
                                const f32x4 o = v[2 * hh + q] * rstd * g4 * (sc + 1.0f) + sh;
                                if (q == 0) { w.x = pk2(o[0], o[1]); w.y = pk2(o[2], o[3]); } else { w.z = pk2(o[0], o[1]); w.w = pk2(o[2], o[3]); }
                            }
                            *(u32x4*)(ABUF + (size_t)(NLAT + r) * DM + col) = w;
                        }
                    }
                }
            }
        } else if ((ph == 2 || ph == 9) && PH_ON(2)) {
            const bool ev = ph == 2;
            pg8::Gemm g{ABUF, ev ? WE_IN : WO_QKV, MROWS, ev ? EVEN_IN : ODD_IN, DM, DM}; pg8::StaticOrder S; S.init(g.M, g.N, G, bid);
            pg8::EpiQKV E{BIG, g.N, ev ? 1024 : 0, ev ? 1024 : 0, ev ? 2048 : 1280, ev ? 1536 : 1024, ROPE};
            pg8::gemm_phase<pg8::EpiQKV, pg8::StaticOrder, true, true>(lds, g, S, E, tid);
        } else if (ph == 3 && PH_ON(3)) {
            float lam;
            { const float d1 = wave_sum(P.in[I_LQ1][lane] * P.in[I_LK1][lane]), d2 = wave_sum(P.in[I_LQ2][lane] * P.in[I_LK2][lane]); lam = __expf(d1) - __expf(d2) + 0.2f; }
            for (int it = bid; it < 1088; it += G) {
                if (it < 1024) {
                    const int uid = (G == 256) ? (((it >> 8) * 8 + (bid & 7)) * 32 + (bid >> 3)) : it;
                    const int b = uid >> 7, h = (uid >> 5) & 3, qb = uid & 31;
                    diff_attn_unit(lds, BIG, MIX, P.in[I_SUBLN], lam, 0.8f, b * SEQ + qb * 128, h, b * SEQ, 64, NLAT + b * CTXL, 68, tid, wave, lane);
                } else if (it < 1088) { const int u = it - 1024, b = u >> 3, h = (u >> 1) & 3, qb = u & 1;
                    diff_attn_unit(lds, BIG, MIX, P.in[I_SUBLN], lam, 0.8f, NLAT + b * CTXL + qb * 128, h, 0, 0, NLAT + b * CTXL, 4, tid, wave, lane);
                }
            }
            {
                int tid2 = threadIdx.x; asm volatile("" : "+v"(tid2));
                const int lane2 = tid2 & 63, wave2 = __builtin_amdgcn_readfirstlane(tid2 >> 6);
                chunk_mlp_units(lds, BIG, SGU, P.in[I_SGU_B], MIX, (bid + 192) % G, G, 1088, tid2, wave2, lane2);
            }
        } else if ((ph == 4 || ph == 7 || ph == 11 || ph == 14) && PH_ON(4)) {
            const int l = ph >= 8 ? 1 : 0; const bool ffn = (ph == 7 || ph == 14);
            const int KK = ffn ? FFH : DM;
            pg8::Gemm g{ffn ? BIG : MIX, ffn ? WF_OUT + (size_t)l * DM * FFH : (l ? WO_OUT : WE_OUT), NLAT, DM, KK, KK}; pg8::StaticOrder S; S.init(g.M, g.N, G, bid);
            const float* gt = MOD + (size_t)l * 9 * 6144 + (ffn ? 5120 : 2048);
            if (ph == 4) { pg8::EpiRes<true> E{X, CTX, HB, gt}; pg8::gemm_phase<pg8::EpiRes<true>, pg8::StaticOrder, true, true>(lds, g, S, E, tid); }
            else { pg8::EpiRes<false> E{nullptr, nullptr, HB, gt}; pg8::gemm_phase<pg8::EpiRes<false>, pg8::StaticOrder, true, true>(lds, g, S, E, tid); }
            if (l == 0) {
                const int nK = ffn ? 2 : 4;
                pg8::Gemm gc{g.A, g.Bt, MROWS, DM, KK / nK, KK}; pg8::SplitOrder SC{NLAT / 256, NCTX / 256, DM / 256, nK, G, bid};
                pg8::EpiPart EC{PART};
                pg8::gemm_phase<pg8::EpiPart, pg8::SplitOrder, true, true>(lds, gc, SC, EC, tid);
            }
        } else if ((ph == 6 || ph == 13) && PH_ON(6)) {
            const int l = ph == 13 ? 1 : 0;
            pg8::Gemm g{ABUF, WF_IN + (size_t)l * 2 * FFH * DM, l ? NLAT : MROWS, 2 * FFH, DM, DM}; pg8::StaticOrder S; S.init(g.M, g.N, G, bid);
            pg8::EpiSwiglu E{BIG};
            pg8::gemm_phase<pg8::EpiSwiglu, pg8::StaticOrder, true, true>(lds, g, S, E, tid);
        } else if (ph == 10 && PH_ON(10)) {
            for (int it = bid; it < 2048; it += G) win_attn_unit(lds, BIG, MIX, P.in[I_SINK], it >> 8, (it >> 6) & 3, (it & 63) * 64, tid, wave, lane);
        } else if (ph == 15 && PH_ON(15)) {
            const float* fg = P.in[I_FINAL_G];
            for (int row = gw; row < NLAT; row += ngw) {
                f32x4 v[4]; load_row16<true>(HB + (size_t)row * DM, lane, v);
                float ss = 0.f;
#pragma unroll
                for (int j = 0; j < 4; ++j) ss += (v[j][0] * v[j][0] + v[j][1] * v[j][1]) + (v[j][2] * v[j][2] + v[j][3] * v[j][3]);
                const float rstd = 1.0f / sqrtf(wave_sum(ss) * (1.0f / DM) + EPS);
#pragma unroll
                for (int j = 0; j < 4; ++j) { const int col = (j >> 1) * 512 + 8 * lane + 4 * (j & 1); *(f32x4*)(OUT + (size_t)row * DM + col) = v[j] * rstd * *(const f32x4*)(fg + col); }
            }
        }
#if PROBE
        grid.sync();
        { const unsigned long long t_now = __builtin_amdgcn_s_memrealtime(); const unsigned long long d = t_now - t_prev; t_prev = t_now;
          if (ph == 3) cA += d; else if (ph == 10) cC += d; else if (ph == 2 || ph == 4 || ph == 6 || ph == 7 || ph == 9 || ph == 11 || ph == 13 || ph == 14) cB += d; else cD += d; }
#else
        if (pi + 1 < 2 * P.ph_hi) { if (P.ph_lo < 0) grid.sync(); xcd_barrier(xbar); }
#endif
    }
    for (int k = 0; k < EXTRA_SYNCS; ++k) xcd_barrier(xbar);
#if PROBE
    { const float v1 = (float)(PROBE == 1 ? cA : cC) * 0.01f * 100.0f, v2 = (float)(PROBE == 1 ? cB : cD) * 0.01f;
      if (bid == 0 && threadIdx.x == 0) OUT[0] = v1;
      for (int i = bid * 512 + threadIdx.x; i < 1048576; i += (int)gridDim.x * 512) OUT[1 + i] = v2; }
#endif
}

extern "C" void kernel_launch(void* const* d_in, const int* in_sizes, int n_in, void* d_out, int out_size, void* d_ws, size_t ws_size, hipStream_t stream) {
    static int grid = 0;
    if (grid == 0) {
        if (n_in != 23 || ws_size < WS_END) { fprintf(stderr, "kernel_launch: unexpected n_in %d / ws %zu (need %zu)\n", n_in, ws_size, (size_t)WS_END); grid = -1; return; }
        int dev = 0, cus = 0, per_cu = 0;
        (void)hipGetDevice(&dev);
        (void)hipDeviceGetAttribute(&cus, hipDeviceAttributeMultiprocessorCount, dev);
        if (hipFuncSetAttribute((const void*)mega_fwd, hipFuncAttributeMaxDynamicSharedMemorySize, LDS_BYTES) != hipSuccess) fprintf(stderr, "kernel_launch: hipFuncSetAttribute failed\n");
        if (hipOccupancyMaxActiveBlocksPerMultiprocessor(&per_cu, (const void*)mega_fwd, 512, LDS_BYTES) != hipSuccess || per_cu < 1) { fprintf(stderr, "kernel_launch: occupancy query gave %d\n", per_cu); per_cu = 1; }
        (void)hipGetLastError();
        grid = cus * (per_cu > 1 ? 1 : per_cu);
        if (grid <= 0) grid = 256;
    }
    if (grid < 0) return;
    if (hipMemsetAsync((unsigned char*)d_ws + WS_BAR, 0, 16384, stream) != hipSuccess) fprintf(stderr, "kernel_launch: hipMemsetAsync failed\n");
    Params p{};
    for (int i = 0; i < 23; ++i) p.in[i] = (const float*)d_in[i];
    p.out = (float*)d_out; p.ws = (unsigned char*)d_ws; p.ph_lo = 0; p.ph_hi = NPHASE;
    void* args[] = {&p};
    hipError_t e = hipLaunchCooperativeKernel((const void*)mega_fwd, dim3(grid), dim3(512), args, LDS_BYTES, stream);
    if (e != hipSuccess) fprintf(stderr, "kernel_launch: cooperative launch failed: %s (grid %d)\n", hipGetErrorString(e), grid);
}
```
